# Optimizing an MI355X kernel written in HIP

```python
import jax
import jax.numpy as jnp
from jax import lax
import numpy as np


D_MODEL = 1024
BATCH = 8
SEQ = 2048
DEPTH = 2

MEM_LEN = 256
N_BRANCH = 4
BRANCH_W = 512
BLOCK_Q = 128
A_GROUPS = 4
A_CHUNK = 128
A_GW = BRANCH_W // A_GROUPS
B_HEADS = 8
B_KV = 2
B_GQ = B_HEADS // B_KV
B_HD = 64
CMP_LEN = 32
CMP_STRIDE = 16
SEL_LEN = 64
SEL_N = 8
WIN = 256
C_HEADS = 8
C_HD = 64
M_HEADS = 4
M_HD = BRANCH_W // M_HEADS
ROPE_THETA = 10000.0
EPS = 1e-6
NEG = -1e30
BIG = 1e9

IN_SIZES = (
    BRANCH_W, BRANCH_W, BRANCH_W,
    B_HEADS * B_HD, B_KV * B_HD, B_KV * B_HD, B_KV * B_HD,
    B_KV * B_HD, B_KV * B_HD, B_KV * B_HD, B_HEADS * 3, BRANCH_W,
    C_HEADS * C_HD, C_HEADS * C_HD, C_HEADS * C_HD, C_HEADS, BRANCH_W,
    M_HEADS * M_HD, BRANCH_W,
)
D_IN = int(sum(IN_SIZES))
IN_SPLITS = tuple(int(c) for c in np.cumsum(IN_SIZES)[:-1])

kernel_name = 'hybrid_gmlp_nsa_fox_mem_block'


def rms_norm(x, g):
    xf = x.astype(jnp.float32)
    y = xf * lax.rsqrt(jnp.mean(xf * xf, axis=-1, keepdims=True) + EPS)
    return (y * g.astype(jnp.float32)).astype(x.dtype)


def layer_norm(x, g, b):
    xf = x.astype(jnp.float32)
    mu = jnp.mean(xf, axis=-1, keepdims=True)
    xc = xf - mu
    y = xc * lax.rsqrt(jnp.mean(xc * xc, axis=-1, keepdims=True) + EPS)
    return (y * g.astype(jnp.float32) + b.astype(jnp.float32)).astype(x.dtype)


def rope(x, pos):
    half = x.shape[-1] // 2
    freqs = ROPE_THETA ** (-jnp.arange(half, dtype=jnp.float32) / half)
    ang = pos.astype(jnp.float32)[:, None] * freqs[None, :]
    cos, sin = jnp.cos(ang), jnp.sin(ang)
    xf = x.astype(jnp.float32)
    x1, x2 = xf[..., :half], xf[..., half:]
    return jnp.concatenate([x1 * cos - x2 * sin, x1 * sin + x2 * cos], axis=-1).astype(x.dtype)


def masked_softmax(s, mask):
    p = jax.nn.softmax(jnp.where(mask, s, NEG), axis=-1)
    return jnp.where(mask, p, 0.0)


def chunked_gmlp(u, v, ln_g, ln_b, w_s, b_s):
    Bn, S, W = u.shape
    u = jax.nn.gelu(u)
    v = layer_norm(jax.nn.gelu(v), ln_g, ln_b)
    vc = v.reshape(Bn, S // A_CHUNK, A_CHUNK, A_GROUPS, A_GW)
    tri = np.tril(np.ones((A_CHUNK, A_CHUNK), dtype=bool))
    ws = jnp.where(tri, w_s, 0.0)
    s = jnp.einsum('gts,bcsgd->bctgd', ws, vc) + b_s.T[None, None, :, :, None]
    return u * s.reshape(Bn, S, W)


def compress(k, pos_emb, w1, w2):
    S = k.shape[2]
    nc = (S - CMP_LEN) // CMP_STRIDE + 1
    idx = np.arange(nc)[:, None] * CMP_STRIDE + np.arange(CMP_LEN)[None, :]
    blocks = k[:, :, idx] + pos_emb
    flat = blocks.reshape(blocks.shape[0], blocks.shape[1], nc, CMP_LEN * B_HD)
    return jax.nn.silu(flat @ w1) @ w2


def nsa_attention(q, kc, vc, ks, vs, kw, vw, gate_logits, pos_k, w1_k, w2_k, pos_v, w1_v, w2_v):
    Bn, S, _ = q.shape
    pos = jnp.arange(S)
    scale = B_HD ** -0.5
    q = rope(q.reshape(Bn, S, B_KV, B_GQ, B_HD).transpose(0, 2, 3, 1, 4), pos)
    kv_heads = lambda t: t.reshape(Bn, S, B_KV, B_HD).transpose(0, 2, 1, 3)
    kc, ks, kw = [rope(kv_heads(t), pos) for t in (kc, ks, kw)]
    vc, vs, vw = [kv_heads(t) for t in (vc, vs, vw)]

    kcmp = compress(kc, pos_k, w1_k, w2_k)
    vcmp = compress(vc, pos_v, w1_v, w2_v)
    nc = kcmp.shape[2]
    cmp_ok = (np.arange(nc) * CMP_STRIDE + CMP_LEN - 1)[None, :] <= np.arange(S)[:, None]
    s = jnp.einsum('bgrtd,bgcd->bgrtc', q, kcmp, preferred_element_type=jnp.float32) * scale
    p_cmp = masked_softmax(s, cmp_ok)
    o_cmp = jnp.einsum('bgrtc,bgcd->bgrtd', p_cmp.astype(vcmp.dtype), vcmp)

    nsel = S // SEL_LEN
    n_sel = min(SEL_N, nsel)
    ci = np.arange(nc) * CMP_STRIDE
    sj = np.arange(nsel) * SEL_LEN
    overlap = ((ci[:, None] <= sj[None, :] + SEL_LEN - 1) & (ci[:, None] + CMP_LEN - 1 >= sj[None, :])).astype(np.float32)
    imp = jnp.einsum('bgrtc,cj->bgtj', p_cmp, overlap)
    cur = np.arange(S) // SEL_LEN
    blk = np.arange(nsel)
    forced = (blk[None, :] == 0) | (blk[None, :] == cur[:, None]) | (blk[None, :] == cur[:, None] - 1)
    future = blk[None, :] > cur[:, None]
    imp = jnp.where(forced, BIG, jnp.where(future, NEG, imp))
    _, sel_idx = lax.top_k(imp, n_sel)

    nb = S // BLOCK_Q
    q_blk = q.reshape(Bn, B_KV, B_GQ, nb, BLOCK_Q, B_HD).transpose(3, 0, 1, 2, 4, 5)
    idx_blk = sel_idx.reshape(Bn, B_KV, nb, BLOCK_Q, n_sel).transpose(2, 0, 1, 3, 4)
    ks_b = ks.reshape(Bn, B_KV, nsel, SEL_LEN, B_HD)
    vs_b = vs.reshape(Bn, B_KV, nsel, SEL_LEN, B_HD)
    kpad = jnp.pad(kw, ((0, 0), (0, 0), (WIN, 0), (0, 0)))
    vpad = jnp.pad(vw, ((0, 0), (0, 0), (WIN, 0), (0, 0)))
    bi = jnp.arange(Bn)[:, None, None, None]
    gi = jnp.arange(B_KV)[None, :, None, None]
    n_keys = n_sel * SEL_LEN

    def block_fn(args):
        qb, idxb, i = args
        qs = i * BLOCK_Q
        tq = qs + jnp.arange(BLOCK_Q)
        kg = ks_b[bi, gi, idxb].reshape(Bn, B_KV, BLOCK_Q, n_keys, B_HD)
        vg = vs_b[bi, gi, idxb].reshape(Bn, B_KV, BLOCK_Q, n_keys, B_HD)
        kpos = (idxb[..., None] * SEL_LEN + jnp.arange(SEL_LEN)).reshape(Bn, B_KV, BLOCK_Q, n_keys)
        sel_ok = (kpos <= tq[:, None])[:, :, None]
        s_sel = jnp.einsum('bgrtd,bgtkd->bgrtk', qb, kg, preferred_element_type=jnp.float32) * scale
        o_sel = jnp.einsum('bgrtk,bgtkd->bgrtd', masked_softmax(s_sel, sel_ok).astype(vg.dtype), vg)
        kwin = lax.dynamic_slice_in_dim(kpad, qs, WIN + BLOCK_Q, axis=2)
        vwin = lax.dynamic_slice_in_dim(vpad, qs, WIN + BLOCK_Q, axis=2)
        wpos = qs - WIN + jnp.arange(WIN + BLOCK_Q)
        win_ok = (wpos[None, :] <= tq[:, None]) & (wpos[None, :] > tq[:, None] - WIN) & (wpos[None, :] >= 0)
        s_win = jnp.einsum('bgrtd,bgkd->bgrtk', qb, kwin, preferred_element_type=jnp.float32) * scale
        o_win = jnp.einsum('bgrtk,bgkd->bgrtd', masked_softmax(s_win, win_ok).astype(vwin.dtype), vwin)
        return o_sel, o_win

    o_sel, o_win = lax.map(block_fn, (q_blk, idx_blk, jnp.arange(nb)))
    o_sel = o_sel.transpose(1, 2, 3, 0, 4, 5).reshape(Bn, B_KV, B_GQ, S, B_HD)
    o_win = o_win.transpose(1, 2, 3, 0, 4, 5).reshape(Bn, B_KV, B_GQ, S, B_HD)

    g = jax.nn.sigmoid(gate_logits.astype(jnp.float32)).reshape(Bn, S, B_KV, B_GQ, 3).transpose(0, 2, 3, 1, 4).astype(q.dtype)
    o = g[..., 0:1] * o_cmp + g[..., 1:2] * o_sel + g[..., 2:3] * o_win
    return o.transpose(0, 3, 1, 2, 4).reshape(Bn, S, B_HEADS * B_HD)


def forgetting_attention(q, k, v, f_logit, f_bias):
    Bn, S, _ = q.shape
    heads = lambda t: t.reshape(Bn, S, C_HEADS, C_HD).transpose(0, 2, 1, 3)
    q, k, v = heads(q), heads(k), heads(v)
    log_f = jax.nn.log_sigmoid(f_logit.astype(jnp.float32) + f_bias.astype(jnp.float32))
    c = jnp.cumsum(log_f, axis=1).transpose(0, 2, 1)
    scale = C_HD ** -0.5
    outs = []
    for i in range(S // BLOCK_Q):
        qs, qe = i * BLOCK_Q, (i + 1) * BLOCK_Q
        s = jnp.einsum('bhtd,bhsd->bhts', q[:, :, qs:qe], k[:, :, :qe], preferred_element_type=jnp.float32) * scale
        s = s + c[:, :, qs:qe, None] - c[:, :, None, :qe]
        causal = np.arange(qe)[None, :] <= np.arange(qs, qe)[:, None]
        p = masked_softmax(s, causal)
        outs.append(jnp.einsum('bhts,bhsd->bhtd', p.astype(v.dtype), v[:, :, :qe]))
    o = jnp.concatenate(outs, axis=2)
    return o.transpose(0, 2, 1, 3).reshape(Bn, S, C_HEADS * C_HD)


def memory_attention(q, mem, g_mem, w_mem_kv):
    Bn, S, _ = q.shape
    mkv = rms_norm(mem, g_mem) @ w_mem_kv
    mk, mv = jnp.split(mkv, 2, axis=-1)
    heads = lambda t: t.reshape(t.shape[0], t.shape[1], M_HEADS, M_HD).transpose(0, 2, 1, 3)
    s = jnp.einsum('bhtd,bhmd->bhtm', heads(q), heads(mk), preferred_element_type=jnp.float32) * (M_HD ** -0.5)
    p = jax.nn.softmax(s, axis=-1)
    o = jnp.einsum('bhtm,bhmd->bhtd', p.astype(mv.dtype), heads(mv))
    return o.transpose(0, 2, 1, 3).reshape(Bn, S, M_HEADS * M_HD)


def hybrid_layer(x, mem, w_in, g_pre, g_post, g_mem, w_mem_kv, a_ln_g, a_ln_b, a_ws, a_bs,
                 b_cmp_pos_k, b_cmp_w1_k, b_cmp_w2_k, b_cmp_pos_v, b_cmp_w1_v, b_cmp_w2_v,
                 c_fbias, w_br, w_gate, w_o):
    h = rms_norm(x, g_pre)
    parts = jnp.split(h @ w_in, IN_SPLITS, axis=-1)
    (a_u, a_v, a_z,
     b_q, b_kc, b_vc, b_ks, b_vs, b_kw, b_vw, b_g, b_z,
     c_q, c_k, c_v, c_f, c_z,
     m_q, m_z) = parts
    y_a = chunked_gmlp(a_u, a_v, a_ln_g, a_ln_b, a_ws, a_bs) * jax.nn.silu(a_z)
    y_b = nsa_attention(b_q, b_kc, b_vc, b_ks, b_vs, b_kw, b_vw, b_g,
                        b_cmp_pos_k, b_cmp_w1_k, b_cmp_w2_k, b_cmp_pos_v, b_cmp_w1_v, b_cmp_w2_v) * jax.nn.silu(b_z)
    y_c = forgetting_attention(c_q, c_k, c_v, c_f, c_fbias) * jax.nn.silu(c_z)
    y_m = memory_attention(m_q, mem, g_mem, w_mem_kv) * jax.nn.silu(m_z)
    ys = jnp.stack([y_a, y_b, y_c, y_m], axis=2)
    up = jnp.einsum('bsnw,nwd->bsnd', ys, w_br)
    gates = jax.nn.sigmoid(jnp.einsum('bsd,dne->bsne', h, w_gate))
    merged = jnp.einsum('bsnd,bsnd->bsd', gates, up)
    out = merged @ w_o
    return x + rms_norm(out, g_post)


def setup_inputs(seed: int = 0) -> dict:
    key = jax.random.key(seed)
    k = jax.random.split(key, 21)
    f32 = jnp.float32
    nrm = lambda kk, shape, sc: jax.random.normal(kk, shape, f32) * sc
    L, D = DEPTH, D_MODEL
    return {
        'x': nrm(k[0], (BATCH, SEQ, D), 1.0),
        'mem': nrm(k[1], (BATCH, MEM_LEN, D), 1.0),
        'w_in': nrm(k[2], (L, D, D_IN), D ** -0.5),
        'g_pre': 1.0 + nrm(k[3], (L, D), 0.02),
        'g_post': 1.0 + nrm(k[4], (L, D), 0.02),
        'g_mem': 1.0 + nrm(k[5], (L, D), 0.02),
        'w_mem_kv': nrm(k[6], (L, D, 2 * BRANCH_W), D ** -0.5),
        'a_ln_g': 1.0 + nrm(k[7], (L, BRANCH_W), 0.02),
        'a_ln_b': nrm(k[8], (L, BRANCH_W), 0.02),
        'a_ws': nrm(k[9], (L, A_GROUPS, A_CHUNK, A_CHUNK), A_CHUNK ** -0.5),
        'a_bs': 1.0 + nrm(k[10], (L, A_GROUPS, A_CHUNK), 0.1),
        'b_cmp_pos_k': nrm(k[11], (L, CMP_LEN, B_HD), 0.02),
        'b_cmp_w1_k': nrm(k[12], (L, CMP_LEN * B_HD, B_HD), (CMP_LEN * B_HD) ** -0.5),
        'b_cmp_w2_k': nrm(k[13], (L, B_HD, B_HD), B_HD ** -0.5),
        'b_cmp_pos_v': nrm(k[14], (L, CMP_LEN, B_HD), 0.02),
        'b_cmp_w1_v': nrm(k[15], (L, CMP_LEN * B_HD, B_HD), (CMP_LEN * B_HD) ** -0.5),
        'b_cmp_w2_v': nrm(k[16], (L, B_HD, B_HD), B_HD ** -0.5),
        'c_fbias': 2.0 + nrm(k[17], (L, C_HEADS), 0.5),
        'w_br': nrm(k[18], (L, N_BRANCH, BRANCH_W, D), BRANCH_W ** -0.5),
        'w_gate': nrm(k[19], (L, D, N_BRANCH, D), D ** -0.5),
        'w_o': nrm(k[20], (L, D, D), D ** -0.5),
    }


def reference(x, mem, w_in, g_pre, g_post, g_mem, w_mem_kv, a_ln_g, a_ln_b, a_ws, a_bs,
              b_cmp_pos_k, b_cmp_w1_k, b_cmp_w2_k, b_cmp_pos_v, b_cmp_w1_v, b_cmp_w2_v,
              c_fbias, w_br, w_gate, w_o):
    for l in range(DEPTH):
        x = hybrid_layer(x, mem, w_in[l], g_pre[l], g_post[l], g_mem[l], w_mem_kv[l],
                         a_ln_g[l], a_ln_b[l], a_ws[l], a_bs[l],
                         b_cmp_pos_k[l], b_cmp_w1_k[l], b_cmp_w2_k[l],
                         b_cmp_pos_v[l], b_cmp_w1_v[l], b_cmp_w2_v[l],
                         c_fbias[l], w_br[l], w_gate[l], w_o[l])
    return x
```

```cpp
#include <hip/hip_runtime.h>
#include <hip/hip_cooperative_groups.h>
#include <cstdio>
#include <cstdint>
#include <cmath>
namespace cg = cooperative_groups;
#ifndef ONE_LAUNCH
#define ONE_LAUNCH 1
#endif
namespace pg8 {
#define PG8_LAS __attribute__((address_space(3)))
typedef unsigned short bf16_t;
typedef short bf16x8 __attribute__((ext_vector_type(8)));
typedef float f32x4 __attribute__((ext_vector_type(4)));
typedef unsigned u32x4 __attribute__((ext_vector_type(4)));
constexpr int BM = 256, BK = 64, HALF = 128, HTB = HALF * BK * 2  , STAGE_BYTES = 8 * HTB, NXCD = 8, WGM = 8;

__host__ __device__ __forceinline__ int lds_byte(int r, int c) { const int st = (r >> 4) * 2 + (c >> 5), rr = r & 15, cc = c & 31, ob = rr * 64 + cc * 2; return st * 1024 + (ob ^ (((ob >> 9) & 1) << 5)); }
__host__ __device__ __forceinline__ void stage_rc(int b, int& R, int& C) { const int st = b / 1024, sb = b % 1024, swz = sb ^ (((sb >> 9) & 1) << 5); R = (st >> 1) * 16 + swz / 64; C = (st & 1) * 32 + (swz % 64) / 2; }
__host__ __device__ __forceinline__ int perm32(int rho) { const int n = rho >> 4, i = rho & 15; return 8 * (i >> 2) + 4 * n + (i & 3); }

struct Unit { int pm, pn; };
struct Gemm { const bf16_t* A; const bf16_t* Bt; int M, N, K; };

struct StaticOrder {
    int nM, nN, nwg, G, c;
    __host__ __device__ void init(int M, int N, int G_, int c_) { nM = M / BM; nN = N / BM; nwg = nM * nN; G = G_; c = c_; }
    __host__ __device__ bool next(int i, Unit& u) const {
        const long L = (long)i * G + c; if (L >= nwg) return false;
        int wgid = (int)L; { const int q = nwg / NXCD, r = nwg % NXCD, xcd = wgid % NXCD, off = wgid / NXCD; wgid = (xcd < r ? xcd * (q + 1) : r * (q + 1) + (xcd - r) * q) + off; }
        const int nig = WGM * nN, gid = wgid / nig, fm = gid * WGM, gsz = (nM - fm) < WGM ? (nM - fm) : WGM;
        u.pm = fm + ((wgid % nig) % gsz); u.pn = (wgid % nig) / gsz; return true;
    }
    __device__ __forceinline__ void a_ready(const Unit&) const {}
    __device__ __forceinline__ void done(const Unit&) const {}
};

template <class Epi, class Sched, bool ALIGN_EPI = false, bool SP2 = false>
__device__ __forceinline__ void gemm_phase(PG8_LAS unsigned char* lds, const Gemm g, const Sched& S, const Epi& E, const int tid) {
    const int wid = __builtin_amdgcn_readfirstlane(tid >> 6), lane = tid & 63, wr = wid >> 2, wc = wid & 3, fr = lane & 15, fq = lane >> 4;
    const int K = g.K, nt = K / BK;
    unsigned voffA[2], voffB[2];
#pragma unroll
    for (int i = 0; i < 2; ++i) { int R, C; stage_rc(tid * 16 + i * 8192, R, C); const int Rb = Epi::PERM ? ((R & ~31) + perm32(R & 31)) : R;
        voffA[i] = (unsigned)(R * K + C) * 2u; voffB[i] = (unsigned)(Rb * K + C) * 2u; }
    const size_t kstep = (size_t)(BK * 2);
    const size_t hstep = (size_t)HALF * K * 2;
    const size_t tstep = 2 * hstep;
    const unsigned ldsw = (unsigned)wid * 1024u;
    const int aoff = lds_byte(wr * 64 + fr, fq * 8), boff = lds_byte(wc * 32 + fr, fq * 8);
#define PG8_SA(b, h) (((b) * 2 + (h)) * HTB)
#define PG8_SB(b, h) ((4 + (b) * 2 + (h)) * HTB)
#define PG8_STAGE(bufoff, gbase, voff) do { _Pragma("unroll") for (int _i = 0; _i < 2; ++_i) \
        __builtin_amdgcn_global_load_lds((const unsigned*)((const char*)(gbase) + (voff)[_i]), (PG8_LAS unsigned*)(lds + (bufoff) + ldsw + _i * 8192), 16, 0, 0); } while (0)
#define PG8_LDA(dst, b, h) do { _Pragma("unroll") for (int m = 0; m < 4; ++m) _Pragma("unroll") for (int k = 0; k < 2; ++k) dst[m][k] = *(const PG8_LAS bf16x8*)(lds + PG8_SA(b, h) + aoff + m * 2048 + k * 1024); } while (0)
#define PG8_LDB(dst, b, h) do { _Pragma("unroll") for (int n = 0; n < 2; ++n) _Pragma("unroll") for (int k = 0; k < 2; ++k) dst[n][k] = *(const PG8_LAS bf16x8*)(lds + PG8_SB(b, h) + boff + n * 2048 + k * 1024); } while (0)
#define PG8_MMA(ai, bj, At, Bt) do { __builtin_amdgcn_s_setprio(1); _Pragma("unroll") for (int m = 0; m < 4; ++m) _Pragma("unroll") for (int n = 0; n < 2; ++n) _Pragma("unroll") for (int k = 0; k < 2; ++k) \
        acc[ai][bj][m][n] = __builtin_amdgcn_mfma_f32_16x16x32_bf16(Bt[n][k], At[m][k], acc[ai][bj][m][n], 0, 0, 0); __builtin_amdgcn_s_setprio(0); } while (0)
#define PG8_WAIT_V(n) asm volatile("s_waitcnt vmcnt(" #n ")" ::: "memory")
#define PG8_WAIT_L(n) asm volatile("s_waitcnt lgkmcnt(" #n ")" ::: "memory")
#define PG8_BAR __builtin_amdgcn_s_barrier()
#define PG8_SCHED __builtin_amdgcn_sched_barrier(0)
    Unit cur, nxt; int ui = 0;
    if (!S.next(0, cur)) return;
    f32x4 acc[2][2][4][2];
#pragma unroll
    for (int a = 0; a < 2; ++a)
#pragma unroll
        for (int b = 0; b < 2; ++b)
#pragma unroll
            for (int m = 0; m < 4; ++m)
#pragma unroll
                for (int n = 0; n < 2; ++n) acc[a][b][m][n] = (f32x4){0.f, 0.f, 0.f, 0.f};
    bf16x8 At[4][2], B0[2][2], B1[2][2];
    const char* cA = (const char*)g.A + (size_t)cur.pm * tstep; const char* cB = (const char*)g.Bt + (size_t)cur.pn * tstep;
    S.a_ready(cur);
    if constexpr (SP2) {
        PG8_STAGE(PG8_SB(0, 0), cB, voffB); PG8_STAGE(PG8_SB(0, 1), cB + hstep, voffB); PG8_STAGE(PG8_SA(0, 0), cA, voffA); PG8_STAGE(PG8_SA(0, 1), cA + hstep, voffA);
        if (wr == 1) PG8_BAR;
        PG8_WAIT_V(2); PG8_BAR;
        PG8_STAGE(PG8_SB(1, 0), cB + kstep, voffB); PG8_STAGE(PG8_SA(1, 0), cA + kstep, voffA); PG8_STAGE(PG8_SB(1, 1), cB + hstep + kstep, voffB);
        PG8_WAIT_V(6); PG8_BAR;
    } else {
        PG8_STAGE(PG8_SB(0, 0), cB, voffB); PG8_STAGE(PG8_SA(0, 0), cA, voffA); PG8_STAGE(PG8_SB(0, 1), cB + hstep, voffB); PG8_STAGE(PG8_SA(0, 1), cA + hstep, voffA);
        if (wr == 1) PG8_BAR;
        PG8_WAIT_V(4); PG8_BAR;
        PG8_STAGE(PG8_SB(1, 0), cB + kstep, voffB); PG8_STAGE(PG8_SA(1, 0), cA + kstep, voffA); PG8_STAGE(PG8_SB(1, 1), cB + hstep + kstep, voffB);
        PG8_WAIT_V(6); PG8_BAR;
    }
    for (;;) {
        const bool has_next = S.next(ui + 1, nxt);
        const char* nA = has_next ? (const char*)g.A + (size_t)nxt.pm * tstep : cA; const char* nB = has_next ? (const char*)g.Bt + (size_t)nxt.pn * tstep : cB;
        for (int t = 0; t < nt; t += 2) {
            const bool last = (t == nt - 2);
            const char* a1 = cA + (size_t)(t + 1) * kstep;
            const char* a2 = last ? nA : cA + (size_t)(t + 2) * kstep; const char* b2 = last ? nB : cB + (size_t)(t + 2) * kstep;
            const char* a3 = a2 + kstep; const char* b3 = b2 + kstep;
            if (last && has_next) S.a_ready(nxt);
            if constexpr (SP2) {
            PG8_LDB(B0, 0, 0); PG8_LDB(B1, 0, 1); PG8_SCHED; PG8_LDA(At, 0, 0); PG8_STAGE(PG8_SA(1, 1), a1 + hstep, voffA);
            PG8_WAIT_V(8); PG8_WAIT_L(0); PG8_BAR; PG8_MMA(0, 0, At, B0); PG8_MMA(0, 1, At, B1); PG8_BAR; PG8_SCHED;
            PG8_LDA(At, 0, 1); PG8_STAGE(PG8_SB(0, 0), b2, voffB); PG8_STAGE(PG8_SB(0, 1), b2 + hstep, voffB); PG8_STAGE(PG8_SA(0, 0), a2, voffA);
            PG8_WAIT_V(8); PG8_WAIT_L(0); PG8_BAR; PG8_MMA(1, 0, At, B0); PG8_MMA(1, 1, At, B1); PG8_BAR; PG8_SCHED;
            PG8_LDB(B0, 1, 0); PG8_LDB(B1, 1, 1); PG8_SCHED; PG8_LDA(At, 1, 0); PG8_STAGE(PG8_SA(0, 1), a2 + hstep, voffA);
            PG8_WAIT_V(8); PG8_WAIT_L(0); PG8_BAR; PG8_MMA(0, 0, At, B0); PG8_MMA(0, 1, At, B1); PG8_BAR; PG8_SCHED;
            PG8_LDA(At, 1, 1); PG8_STAGE(PG8_SB(1, 0), b3, voffB); PG8_STAGE(PG8_SB(1, 1), b3 + hstep, voffB); PG8_STAGE(PG8_SA(1, 0), a3, voffA);
            PG8_WAIT_V(8); PG8_WAIT_L(0); PG8_BAR; PG8_MMA(1, 0, At, B0); PG8_MMA(1, 1, At, B1); PG8_BAR; PG8_SCHED;
            } else {
            PG8_LDB(B0, 0, 0); PG8_SCHED; PG8_LDA(At, 0, 0); PG8_STAGE(PG8_SA(1, 1), a1 + hstep, voffA);
            PG8_WAIT_L(8); PG8_BAR; PG8_WAIT_L(0); PG8_MMA(0, 0, At, B0); PG8_BAR; PG8_SCHED;
            PG8_LDB(B1, 0, 1); PG8_STAGE(PG8_SB(0, 0), b2, voffB);
            PG8_BAR; PG8_WAIT_L(0); PG8_MMA(0, 1, At, B1); PG8_BAR;
            PG8_LDA(At, 0, 1); PG8_STAGE(PG8_SA(0, 0), a2, voffA);
            PG8_BAR; PG8_WAIT_L(0); PG8_MMA(1, 0, At, B0); PG8_BAR; PG8_SCHED;
            PG8_STAGE(PG8_SB(0, 1), b2 + hstep, voffB);
            PG8_WAIT_V(6); PG8_BAR; PG8_MMA(1, 1, At, B1); PG8_BAR;
            PG8_LDB(B0, 1, 0); PG8_SCHED; PG8_LDA(At, 1, 0); PG8_STAGE(PG8_SA(0, 1), a2 + hstep, voffA);
            PG8_WAIT_L(8); PG8_BAR; PG8_WAIT_L(0); PG8_MMA(0, 0, At, B0); PG8_BAR; PG8_SCHED;
            PG8_LDB(B1, 1, 1); PG8_STAGE(PG8_SB(1, 0), b3, voffB);
            PG8_BAR; PG8_WAIT_L(0); PG8_MMA(0, 1, At, B1); PG8_BAR;
            PG8_LDA(At, 1, 1); PG8_STAGE(PG8_SA(1, 0), a3, voffA);
            PG8_BAR; PG8_WAIT_L(0); PG8_MMA(1, 0, At, B0); PG8_BAR; PG8_SCHED;
            PG8_STAGE(PG8_SB(1, 1), b3 + hstep, voffB);
            PG8_WAIT_V(6); PG8_BAR; PG8_MMA(1, 1, At, B1); PG8_BAR;
            }
        }
        if constexpr (ALIGN_EPI) { if (wr == 0) PG8_BAR; }
        if constexpr (!Epi::AFTER_DRAIN) { E(acc, cur, wr, wc, fr, fq); S.done(cur); }
        if (!has_next) break;
#pragma unroll
        for (int a = 0; a < 2; ++a)
#pragma unroll
            for (int b = 0; b < 2; ++b)
#pragma unroll
                for (int m = 0; m < 4; ++m)
#pragma unroll
                    for (int n = 0; n < 2; ++n) acc[a][b][m][n] = (f32x4){0.f, 0.f, 0.f, 0.f};
        cur = nxt; cA = nA; cB = nB; ++ui;
        if constexpr (ALIGN_EPI) { if (wr == 1) PG8_BAR; }
    }
    PG8_WAIT_V(0);
    if constexpr (!ALIGN_EPI) { if (wr == 0) PG8_BAR; }
    PG8_BAR;
    if constexpr (Epi::AFTER_DRAIN) { E.fused(acc, cur, wr, wc, fr, fq, lds, wid, lane); S.done(cur); }
#undef PG8_SA
#undef PG8_SB
#undef PG8_STAGE
#undef PG8_LDA
#undef PG8_LDB
#undef PG8_MMA
#undef PG8_WAIT_V
#undef PG8_WAIT_L
#undef PG8_BAR
#undef PG8_SCHED
}
}

#define LAS __attribute__((address_space(3)))
typedef unsigned short bf16;
typedef short bf16x8 __attribute__((ext_vector_type(8)));
typedef short s16x4 __attribute__((ext_vector_type(4)));
typedef float f32x4 __attribute__((ext_vector_type(4)));
typedef float f32x16 __attribute__((ext_vector_type(16)));
typedef unsigned u32x4 __attribute__((ext_vector_type(4)));
typedef unsigned u32x2 __attribute__((ext_vector_type(2)));

constexpr int NB = 8, SEQ = 2048, DM = 1024, NT = NB * SEQ, MEMLEN = 256, NMEM = NB * MEMLEN;
constexpr int D_IN = 6432, NP1 = 6656, NGATE = 4096, NW1 = NP1 + NGATE;
constexpr float EPS = 1e-6f, LOG2E = 1.4426950408889634f;
constexpr float QSC = 0.125f * LOG2E;
constexpr float MSC = 0.08838834764831845f * LOG2E;
constexpr size_t MiB = 1u << 20;
constexpr size_t WS_CTL = 0;
constexpr size_t WS_ROPEC = 1 * MiB, WS_ROPES = WS_ROPEC + 256 * 1024;
constexpr size_t WS_RINV = WS_ROPES + 256 * 1024;
constexpr size_t WS_RINVM = WS_RINV + 64 * 1024;
constexpr size_t WS_BIAS1 = WS_RINVM + 8 * 1024;
constexpr size_t WS_CS = 2 * MiB;
constexpr size_t WS_KCMP = WS_CS + 512 * 1024, WS_VCMP = WS_KCMP + 256 * 1024;
constexpr size_t WS_PART = 3 * MiB;
constexpr size_t WS_SM = 4 * MiB;
constexpr size_t WS_W = 6 * MiB;
constexpr size_t W_IN = 0, W_BR = 21 * MiB, W_O = 25 * MiB, W_M = 27 * MiB, W_1K = 29 * MiB, W_1V = W_1K + 256 * 1024, W_2K = W_1V + 256 * 1024, W_2V = W_2K + 8192, W_WS = W_2K + 256 * 1024;
constexpr size_t WS_XB = 38 * MiB, WS_MEMB = 70 * MiB, WS_MKV = 74 * MiB, WS_SLOT = 78 * MiB, SLOTB = 16 * MiB;
constexpr size_t WS_KVS = 222 * MiB;
constexpr size_t WS_MERGED = 206 * MiB;
constexpr size_t WS_KX = 246 * MiB, WS_QX = 250 * MiB;
constexpr size_t WS_NEED = 256 * MiB;
constexpr int CW_Q = 64;
constexpr int LDS_BYTES = 147456;
constexpr int LDS_MISC = 143360;

__device__ __forceinline__ unsigned char* wbase(unsigned char* ws, unsigned char* dout, int layer) { return layer ? dout + 32 * MiB : ws + WS_W; }
__device__ __forceinline__ unsigned char* slot_ptr(unsigned char* ws, unsigned char* dout, int i) { return i < 9 ? ws + WS_SLOT + (size_t)i * SLOTB : dout + (size_t)(i - 9) * SLOTB; }
enum { SL_U = 0, SL_BQ = 1, SL_CQ = 2, SL_MQ = 3, SL_V = 4, SL_AZ = 5, SL_BZ = 6, SL_CK = 7, SL_CV = 8, SL_CZ = 9, SL_MZ = 10 };
__device__ __forceinline__ unsigned char* gate_ptr(unsigned char* ws, unsigned char* dout, int n) { return slot_ptr(ws, dout, 4 + n); }

__device__ __forceinline__ unsigned cvtpk(float lo, float hi) { typedef float f2 __attribute__((ext_vector_type(2))); typedef __bf16 b2 __attribute__((ext_vector_type(2))); f2 v = {lo, hi}; b2 b = __builtin_convertvector(v, b2); return __builtin_bit_cast(unsigned, b); }
__device__ __forceinline__ float bflo(unsigned w) { return __uint_as_float(w << 16); }
__device__ __forceinline__ float bfhi(unsigned w) { return __uint_as_float(w & 0xffff0000u); }
__device__ __forceinline__ float ex2(float x) { return __builtin_amdgcn_exp2f(x); }
__device__ __forceinline__ float rcp(float x) { return __builtin_amdgcn_rcpf(x); }
__device__ __forceinline__ float sigm(float x) { return rcp(1.f + ex2(-LOG2E * x)); }
__device__ __forceinline__ float silu_f(float x) { return x * sigm(x); }
__device__ __forceinline__ float gelu_f(float x) { const float u = 0.7978845608028654f * (x + 0.044715f * x * x * x); return x * sigm(2.f * u); }
__device__ __forceinline__ float wave_sum(float v) {
#pragma unroll
    for (int o = 1; o < 64; o <<= 1) v += __shfl_xor(v, o);
    return v;
}
__device__ __forceinline__ int crow(int r, int hi) { return (r & 3) + 8 * (r >> 2) + 4 * hi; }
__device__ __forceinline__ int dperm(int pp) { return (pp >> 1) + 32 * (pp & 1); }

__device__ __forceinline__ int proj_src(int p) {
    if (p < 1536) return p;
    if (p < 2432) {
        int base;
        if (p < 2048) base = 1536 + ((p - 1536) & ~63);
        else if (p < 2176) base = 2048 + ((p - 2048) & ~63);
        else if (p < 2304) base = 2304 + ((p - 2176) & ~63);
        else base = 2560 + ((p - 2304) & ~63);
        return base + dperm(p & 63);
    }
    if (p < 2560) return 2176 + (p - 2432);
    if (p < 2688) return 2432 + (p - 2560);
    if (p < 2816) return 2688 + (p - 2688);
    if (p < 3328) return 2840 + (p - 2816);
    if (p < 3840) return 3352 + (p - 3328);
    if (p < 4352) return 3864 + (p - 3840);
    if (p < 4864) return 4376 + (p - 4352);
    if (p < 5376) return 4896 + (p - 4864);
    if (p < 5888) return 5408 + (p - 5376);
    if (p < 6400) return 5920 + (p - 5888);
    if (p < 6424) return 2816 + (p - 6400);
    if (p < 6432) return 4888 + (p - 6424);
    return -1;
}

namespace pg8 {
struct EpiG1 {
    static constexpr bool PERM = true, AFTER_DRAIN = false;
    unsigned char* ws; unsigned char* dout; const float* rinv; const float* fbias; const float* ropec; const float* ropes; float* sm;
    __device__ __forceinline__ void operator()(const f32x4 (&acc)[2][2][4][2], const Unit& u, int wr, int wc, int fr_, int fq_) const {
        int fr = fr_, fq = fq_; asm volatile("" : "+v"(fr), "+v"(fq));
        const int row0 = u.pm * 256 + wr * 64 + fr; const int bt = u.pm >> 3;
        float rv[2][4];
#pragma unroll
        for (int ai = 0; ai < 2; ++ai)
#pragma unroll
            for (int m = 0; m < 4; ++m) rv[ai][m] = rinv[row0 + ai * 128 + m * 16];
#pragma unroll
        for (int bj = 0; bj < 2; ++bj) {
            const int P = u.pn * 256 + bj * 128 + wc * 32;
            if (P >= 6432) continue;
            if (P >= 6400) {
#pragma unroll
                for (int ai = 0; ai < 2; ++ai)
#pragma unroll
                    for (int m = 0; m < 4; ++m) {
                        const int row = row0 + ai * 128 + m * 16; const float r = rv[ai][m];
                        float v[8];
#pragma unroll
                        for (int j = 0; j < 4; ++j) { v[j] = acc[ai][bj][m][0][j] * r; v[4 + j] = acc[ai][bj][m][1][j] * r; }
                        if (fq < 3) {
#pragma unroll
                            for (int j = 0; j < 8; ++j) v[j] = sigm(v[j]);
                        } else {
#pragma unroll
                            for (int j = 0; j < 8; ++j) { const float x = v[j] + fbias[j]; const float ax = fabsf(x);
                                const float sp = __logf(1.f + __expf(-ax));
                                v[j] = (fminf(x, 0.f) - sp) * LOG2E; }
                        }
                        float* d = sm + (size_t)row * 32 + 8 * fq;
                        *(f32x4*)d = (f32x4){v[0], v[1], v[2], v[3]}; *(f32x4*)(d + 4) = (f32x4){v[4], v[5], v[6], v[7]};
                    }
                continue;
            }
            const int seg = P >> 7; int kind = 0, ld = 512, col, rowadd = 0, sl = 0; float sc = 1.f; bf16* dst;
            if (seg < 4) { kind = 0; sl = SL_U; col = P; }
            else if (seg < 8) { kind = 1; sl = SL_V; col = P - 512; }
            else if (seg < 12) { kind = 0; sl = SL_AZ; col = P - 1024; }
            else if (seg < 16) { kind = 3; sl = SL_BQ; col = P - 1536; sc = QSC; }
            else if (seg < 22) { kind = seg < 19 ? 3 : 0; sl = -1; ld = 64; col = P & 63; rowadd = (bt + ((P >> 6) & 1)) * 2048; }
            else if (seg < 26) { kind = 0; sl = SL_BZ; col = P - 2816; }
            else if (seg < 30) { kind = 0; sl = SL_CQ; col = P - 3328; sc = QSC; }
            else if (seg < 34) { kind = 0; sl = SL_CK; col = P - 3840; }
            else if (seg < 38) { kind = 0; sl = SL_CV; col = P - 4352; }
            else if (seg < 42) { kind = 0; sl = SL_CZ; col = P - 4864; }
            else if (seg < 46) { kind = 0; sl = SL_MQ; col = P - 5376; sc = MSC; }
            else { kind = 0; sl = SL_MZ; col = P - 5888; }
            if (sl >= 0) dst = (bf16*)slot_ptr(ws, dout, sl); else dst = (bf16*)(ws + WS_KVS + (size_t)(seg - 16) * 4 * MiB);
            col += 8 * fq;
            const int pi0 = ((P & 63) + 8 * fq) >> 1;
#pragma unroll
            for (int ai = 0; ai < 2; ++ai) {
                f32x4 rc4[4], rs4[4];
                if (kind == 3) {
#pragma unroll
                    for (int m = 0; m < 4; ++m) { const int t = (row0 + ai * 128 + m * 16) & (SEQ - 1); rc4[m] = *(const f32x4*)(ropec + t * 32 + pi0); rs4[m] = *(const f32x4*)(ropes + t * 32 + pi0); }
                }
#pragma unroll
                for (int m = 0; m < 4; ++m) {
                    const int row = row0 + ai * 128 + m * 16; const float r = rv[ai][m];
                    float v[8];
#pragma unroll
                    for (int j = 0; j < 4; ++j) { v[j] = acc[ai][bj][m][0][j] * r; v[4 + j] = acc[ai][bj][m][1][j] * r; }
                    if (kind == 1) {
#pragma unroll
                        for (int j = 0; j < 8; ++j) v[j] = gelu_f(v[j]);
                    } else if (kind == 3) {
                        const f32x4 c4 = rc4[m], s4 = rs4[m];
#pragma unroll
                        for (int j = 0; j < 4; ++j) { const float x1 = v[2 * j], x2 = v[2 * j + 1]; v[2 * j] = x1 * c4[j] - x2 * s4[j]; v[2 * j + 1] = x1 * s4[j] + x2 * c4[j]; }
                    }
                    u32x4 w; w.x = cvtpk(v[0] * sc, v[1] * sc); w.y = cvtpk(v[2] * sc, v[3] * sc); w.z = cvtpk(v[4] * sc, v[5] * sc); w.w = cvtpk(v[6] * sc, v[7] * sc);
                    *(u32x4*)(dst + (size_t)(row + rowadd) * ld + col) = w;
                }
            }
        }
    }
};
struct EpiNone {
    static constexpr bool PERM = true, AFTER_DRAIN = false;
    __device__ __forceinline__ void operator()(const f32x4 (&acc)[2][2][4][2], const Unit&, int, int, int, int) const {
#pragma unroll
        for (int ai = 0; ai < 2; ++ai)
#pragma unroll
            for (int bj = 0; bj < 2; ++bj)
#pragma unroll
                for (int m = 0; m < 4; ++m) asm volatile("" :: "v"(acc[ai][bj][m][0]), "v"(acc[ai][bj][m][1]));
    }
};
struct EpiRowScale {
    static constexpr bool PERM = true, AFTER_DRAIN = false;
    bf16* O; int ldc; const float* rs;
    __device__ __forceinline__ void operator()(const f32x4 (&acc)[2][2][4][2], const Unit& u, int wr, int wc, int fr_, int fq_) const {
        int fr = fr_, fq = fq_; asm volatile("" : "+v"(fr), "+v"(fq));
        const int row0 = u.pm * 256 + wr * 64 + fr;
        float rv[2][4];
#pragma unroll
        for (int ai = 0; ai < 2; ++ai)
#pragma unroll
            for (int m = 0; m < 4; ++m) rv[ai][m] = rs[row0 + ai * 128 + m * 16];
#pragma unroll
        for (int ai = 0; ai < 2; ++ai)
#pragma unroll
            for (int m = 0; m < 4; ++m) { const int row = row0 + ai * 128 + m * 16; const float r = rv[ai][m];
#pragma unroll
                for (int bj = 0; bj < 2; ++bj) { const int col = u.pn * 256 + bj * 128 + wc * 32 + 8 * fq; const f32x4 a = acc[ai][bj][m][0] * r, b = acc[ai][bj][m][1] * r;
                    u32x4 w; w.x = cvtpk(a[0], a[1]); w.y = cvtpk(a[2], a[3]); w.z = cvtpk(b[0], b[1]); w.w = cvtpk(b[2], b[3]);
                    *(u32x4*)(O + (size_t)row * ldc + col) = w; } }
    }
};
struct EpiGate {
    static constexpr bool PERM = true, AFTER_DRAIN = false;
    unsigned char* g0; unsigned char* g1; unsigned char* g2; unsigned char* g3; const float* rinv;
    __device__ __forceinline__ void operator()(const f32x4 (&acc)[2][2][4][2], const Unit& u, int wr, int wc, int fr_, int fq_) const {
        int fr = fr_, fq = fq_; asm volatile("" : "+v"(fr), "+v"(fq));
        const int n = u.pn >> 2, e0 = (u.pn & 3) * 256; unsigned char* G = n == 0 ? g0 : n == 1 ? g1 : n == 2 ? g2 : g3;
        const int row0 = u.pm * 256 + wr * 64 + fr;
        float rv[2][4];
#pragma unroll
        for (int ai = 0; ai < 2; ++ai)
#pragma unroll
            for (int m = 0; m < 4; ++m) rv[ai][m] = rinv[row0 + ai * 128 + m * 16] * (-LOG2E);
#pragma unroll
        for (int ai = 0; ai < 2; ++ai)
#pragma unroll
            for (int m = 0; m < 4; ++m) { const int row = row0 + ai * 128 + m * 16; const float r = rv[ai][m];
#pragma unroll
                for (int bj = 0; bj < 2; ++bj) { const int col = e0 + bj * 128 + wc * 32 + 8 * fq; const f32x4 a = acc[ai][bj][m][0], b = acc[ai][bj][m][1];
                    unsigned w0 = 0u, w1 = 0u;
                    w0 = __builtin_amdgcn_cvt_pk_u8_f32(rcp(__builtin_fmaf(ex2(a[0] * r), 1.f / 255.f, 1.f / 255.f)), 0, w0); w0 = __builtin_amdgcn_cvt_pk_u8_f32(rcp(__builtin_fmaf(ex2(a[1] * r), 1.f / 255.f, 1.f / 255.f)), 1, w0);
                    w0 = __builtin_amdgcn_cvt_pk_u8_f32(rcp(__builtin_fmaf(ex2(a[2] * r), 1.f / 255.f, 1.f / 255.f)), 2, w0); w0 = __builtin_amdgcn_cvt_pk_u8_f32(rcp(__builtin_fmaf(ex2(a[3] * r), 1.f / 255.f, 1.f / 255.f)), 3, w0);
                    w1 = __builtin_amdgcn_cvt_pk_u8_f32(rcp(__builtin_fmaf(ex2(b[0] * r), 1.f / 255.f, 1.f / 255.f)), 0, w1); w1 = __builtin_amdgcn_cvt_pk_u8_f32(rcp(__builtin_fmaf(ex2(b[1] * r), 1.f / 255.f, 1.f / 255.f)), 1, w1);
                    w1 = __builtin_amdgcn_cvt_pk_u8_f32(rcp(__builtin_fmaf(ex2(b[2] * r), 1.f / 255.f, 1.f / 255.f)), 2, w1); w1 = __builtin_amdgcn_cvt_pk_u8_f32(rcp(__builtin_fmaf(ex2(b[3] * r), 1.f / 255.f, 1.f / 255.f)), 3, w1);
                    u32x2 w; w.x = w0; w.y = w1;
                    *(u32x2*)(G + (size_t)row * 1024 + col) = w; } }
    }
};
struct EpiMerge {
    static constexpr bool PERM = true, AFTER_DRAIN = false;
    const unsigned char* g0; const unsigned char* g1; const unsigned char* g2; const unsigned char* g3; bf16* merged;
    __device__ __forceinline__ void operator()(const f32x4 (&acc)[2][2][4][2], const Unit& u, int wr, int wc, int fr_, int fq_) const {
        int fr = fr_, fq = fq_; asm volatile("" : "+v"(fr), "+v"(fq));
        const int n = u.pn >> 2, pn = u.pn & 3, pm = u.pm & 63; const unsigned char* G = n == 0 ? g0 : n == 1 ? g1 : n == 2 ? g2 : g3;
        const int row0 = pm * 256 + wr * 64 + fr; const int col0 = pn * 256 + wc * 32 + 8 * fq;
#pragma unroll
        for (int ai = 0; ai < 2; ++ai) {
            u32x2 gv[4][2]; u32x4 pv[4][2];
#pragma unroll
            for (int m = 0; m < 4; ++m)
#pragma unroll
                for (int bj = 0; bj < 2; ++bj) { const size_t off = (size_t)(row0 + ai * 128 + m * 16) * 1024 + col0 + bj * 128; gv[m][bj] = *(const u32x2*)(G + off); if (n > 0) pv[m][bj] = *(const u32x4*)(merged + off); }
#pragma unroll
            for (int m = 0; m < 4; ++m)
#pragma unroll
                for (int bj = 0; bj < 2; ++bj) { const size_t off = (size_t)(row0 + ai * 128 + m * 16) * 1024 + col0 + bj * 128;
                    const u32x2 g = gv[m][bj]; const f32x4 a = acc[ai][bj][m][0] * (1.f / 255.f), b = acc[ai][bj][m][1] * (1.f / 255.f);
                    float v[8] = {a[0] * (float)(g.x & 255u), a[1] * (float)((g.x >> 8) & 255u), a[2] * (float)((g.x >> 16) & 255u), a[3] * (float)(g.x >> 24),
                                  b[0] * (float)(g.y & 255u), b[1] * (float)((g.y >> 8) & 255u), b[2] * (float)((g.y >> 16) & 255u), b[3] * (float)(g.y >> 24)};
                    if (n > 0) { const u32x4 p = pv[m][bj];
                        v[0] += bflo(p.x); v[1] += bfhi(p.x); v[2] += bflo(p.y); v[3] += bfhi(p.y); v[4] += bflo(p.z); v[5] += bfhi(p.z); v[6] += bflo(p.w); v[7] += bfhi(p.w); }
                    u32x4 w; w.x = cvtpk(v[0], v[1]); w.y = cvtpk(v[2], v[3]); w.z = cvtpk(v[4], v[5]); w.w = cvtpk(v[6], v[7]);
                    *(u32x4*)(merged + off) = w; }
        }
    }
};
struct MergeOrder {
    StaticOrder base;
    __device__ void init(int G, int c) { base.init(NT, DM, G, c); }
    __device__ bool next(int i, Unit& u) const { if (!base.next(i >> 2, u)) return false; const int n = i & 3; u.pm += 64 * n; u.pn += 4 * n; return true; }
    __device__ __forceinline__ void a_ready(const Unit&) const {}
    __device__ __forceinline__ void done(const Unit&) const {}
};
struct EpiOut {
    static constexpr bool PERM = true, AFTER_DRAIN = false;
    bf16* out; float* part;
    __device__ __forceinline__ void operator()(const f32x4 (&acc)[2][2][4][2], const Unit& u, int wr, int wc, int fr_, int fq_) const {
        int fr = fr_, fq = fq_; asm volatile("" : "+v"(fr), "+v"(fq));
        const int row0 = u.pm * 256 + wr * 64 + fr; const int col0 = u.pn * 256 + wc * 32 + 8 * fq;
#pragma unroll
        for (int ai = 0; ai < 2; ++ai)
#pragma unroll
            for (int m = 0; m < 4; ++m) { const int row = row0 + ai * 128 + m * 16; float ss = 0.f;
#pragma unroll
                for (int bj = 0; bj < 2; ++bj) { const f32x4 a = acc[ai][bj][m][0], b = acc[ai][bj][m][1];
                    ss += ((a[0] * a[0] + a[1] * a[1]) + (a[2] * a[2] + a[3] * a[3])) + ((b[0] * b[0] + b[1] * b[1]) + (b[2] * b[2] + b[3] * b[3]));
                    u32x4 w; w.x = cvtpk(a[0], a[1]); w.y = cvtpk(a[2], a[3]); w.z = cvtpk(b[0], b[1]); w.w = cvtpk(b[2], b[3]);
                    *(u32x4*)(out + (size_t)row * 1024 + col0 + bj * 128) = w; }
                ss += __shfl_xor(ss, 16); ss += __shfl_xor(ss, 32);
                if (fq == 0) part[(size_t)row * 16 + u.pn * 4 + wc] = ss; }
    }
};
}

template <int HD> struct AT {
    static constexpr int ROWB = HD * 2, CPR = HD / 8, NDS = HD / 16, NDB = HD / 32, TILEB = 64 * ROWB, NLD = TILEB / (512 * 16);
    static constexpr int BUFB = 2 * TILEB;
    static constexpr int NB = HD == 64 ? 5 : 3, DEPTH = NB - 1;
    static constexpr int CKOFF = NB * BUFB;
    static constexpr int STGOFF = 0;
    static constexpr int STGROW = ROWB + 16, STGB = 32 * STGROW;
    __device__ static __forceinline__ int fk(int row) { return HD == 64 ? ((row >> 1) & 7) : (row & 15); }
    __device__ static __forceinline__ int fv(int row) { return HD == 64 ? ((row >> 1) & 1) : (row & 3); }
};
typedef short v4i16_t __attribute__((ext_vector_type(4)));
__device__ __forceinline__ s16x4 vtr(const LAS unsigned char* p) { return __builtin_bit_cast(s16x4, __builtin_amdgcn_ds_read_tr16_b64_v4i16((LAS v4i16_t*)p)); }

template <int HD> __device__ __forceinline__ void tile_load(const bf16* g, int ld, int row0, u32x4 (&r)[AT<HD>::NLD], int tid) {
#pragma unroll
    for (int i = 0; i < AT<HD>::NLD; ++i) { const int idx = tid + 512 * i, row = idx / AT<HD>::CPR, ch = idx % AT<HD>::CPR; r[i] = *(const u32x4*)(g + (size_t)(row0 + row) * ld + ch * 8); }
}
template <int HD> __device__ __forceinline__ void tile_store_k(LAS unsigned char* kt, const u32x4 (&r)[AT<HD>::NLD], int tid) {
#pragma unroll
    for (int i = 0; i < AT<HD>::NLD; ++i) { const int idx = tid + 512 * i, row = idx / AT<HD>::CPR, ch = idx % AT<HD>::CPR; *(LAS u32x4*)(kt + row * AT<HD>::ROWB + ((ch ^ AT<HD>::fk(row)) << 4)) = r[i]; }
}
template <int HD> __device__ __forceinline__ void tile_store_v(LAS unsigned char* vt, const u32x4 (&r)[AT<HD>::NLD], int tid) {
#pragma unroll
    for (int i = 0; i < AT<HD>::NLD; ++i) { const int idx = tid + 512 * i, row = idx / AT<HD>::CPR, ch = idx % AT<HD>::CPR; *(LAS u32x4*)(vt + row * AT<HD>::ROWB + ((((ch >> 2) ^ AT<HD>::fv(row))) << 6) + ((ch & 3) << 4)) = r[i]; }
}
template <int HD> __device__ __forceinline__ void qk_tile(const LAS unsigned char* kt, const bf16x8 (&qf)[HD / 16], f32x16& s0, f32x16& s1, int lane) {
    const int r31 = lane & 31, hi = lane >> 5; const int f = AT<HD>::fk(r31); const LAS unsigned char* kb = kt + r31 * AT<HD>::ROWB;
    if constexpr (HD == 64) {
        bf16x8 k0[4], k1[4];
#pragma unroll
        for (int ds = 0; ds < 4; ++ds) { const int off = ((2 * ds + hi) ^ f) << 4; k0[ds] = *(const LAS bf16x8*)(kb + off); k1[ds] = *(const LAS bf16x8*)(kb + 32 * AT<HD>::ROWB + off); }
        __builtin_amdgcn_sched_barrier(0);
#pragma unroll
        for (int ds = 0; ds < 4; ++ds) {
            s0 = __builtin_amdgcn_mfma_f32_32x32x16_bf16(k0[ds], qf[ds], s0, 0, 0, 0);
            s1 = __builtin_amdgcn_mfma_f32_32x32x16_bf16(k1[ds], qf[ds], s1, 0, 0, 0);
        }
    } else {
#pragma unroll
        for (int ds = 0; ds < HD / 16; ++ds) {
            const int off = ((2 * ds + hi) ^ f) << 4;
            const bf16x8 k0 = *(const LAS bf16x8*)(kb + off), k1 = *(const LAS bf16x8*)(kb + 32 * AT<HD>::ROWB + off);
            s0 = __builtin_amdgcn_mfma_f32_32x32x16_bf16(k0, qf[ds], s0, 0, 0, 0);
            s1 = __builtin_amdgcn_mfma_f32_32x32x16_bf16(k1, qf[ds], s1, 0, 0, 0);
        }
    }
}
template <int HD> __device__ __forceinline__ void v_load(const LAS unsigned char* vt, bf16x8 (&vf)[HD / 8], int lane) {
    const int hi = lane >> 5, q = (lane >> 2) & 3; const int fl = HD == 64 ? (q >> 1) : q;
    const LAS unsigned char* vb = vt + (4 * hi + q) * AT<HD>::ROWB + 32 * ((lane >> 4) & 1) + 8 * (lane & 3);
#pragma unroll
    for (int db = 0; db < HD / 32; ++db) {
        const LAS unsigned char* vd = vb + ((db ^ fl) << 6);
#pragma unroll
        for (int ks = 0; ks < 4; ++ks) {
            const s16x4 lo = vtr(vd + (16 * ks) * AT<HD>::ROWB), hh = vtr(vd + (16 * ks + 8) * AT<HD>::ROWB);
            vf[db * 4 + ks] = (bf16x8){lo[0], lo[1], lo[2], lo[3], hh[0], hh[1], hh[2], hh[3]};
        }
    }
}
__device__ __forceinline__ void p_pack(const f32x16& p0, const f32x16& p1, bf16x8 (&pk)[4]) {
#pragma unroll
    for (int s = 0; s < 2; ++s) {
        u32x4 a, b;
        a.x = cvtpk(p0[8 * s + 0], p0[8 * s + 1]); a.y = cvtpk(p0[8 * s + 2], p0[8 * s + 3]); a.z = cvtpk(p0[8 * s + 4], p0[8 * s + 5]); a.w = cvtpk(p0[8 * s + 6], p0[8 * s + 7]);
        b.x = cvtpk(p1[8 * s + 0], p1[8 * s + 1]); b.y = cvtpk(p1[8 * s + 2], p1[8 * s + 3]); b.z = cvtpk(p1[8 * s + 4], p1[8 * s + 5]); b.w = cvtpk(p1[8 * s + 6], p1[8 * s + 7]);
        pk[s] = __builtin_bit_cast(bf16x8, a); pk[2 + s] = __builtin_bit_cast(bf16x8, b);
    }
}
template <int HD> __device__ __forceinline__ void pv_mma(const bf16x8 (&vf)[HD / 8], const bf16x8 (&pk)[4], f32x16 (&o)[HD / 32]) {
    __builtin_amdgcn_s_setprio(1);
#pragma unroll
    for (int db = 0; db < HD / 32; ++db)
#pragma unroll
        for (int ks = 0; ks < 4; ++ks) o[db] = __builtin_amdgcn_mfma_f32_32x32x16_bf16(vf[db * 4 + ks], pk[ks], o[db], 0, 0, 0);
    __builtin_amdgcn_s_setprio(0);
}
template <int HD> __device__ __forceinline__ void pv_tile(const LAS unsigned char* vt, const f32x16& p0, const f32x16& p1, f32x16 (&o)[HD / 32], int lane) {
    bf16x8 vf[HD / 8], pk[4]; v_load<HD>(vt, vf, lane); p_pack(p0, p1, pk); pv_mma<HD>(vf, pk, o);
}
template <int HD, bool EARLYV> __device__ __forceinline__ void softmax_pv(const LAS unsigned char* vt, f32x16& s0, f32x16& s1, f32x16 (&o)[HD / 32], float& m, float& l, int lane) {
    bf16x8 vf[HD / 8];
    if (EARLYV) { v_load<HD>(vt, vf, lane); __builtin_amdgcn_sched_barrier(0); }
    float mx = fmaxf(s0[0], s1[0]);
#pragma unroll
    for (int r = 1; r < 16; ++r) mx = fmaxf(mx, fmaxf(s0[r], s1[r]));
    mx = fmaxf(mx, __shfl_xor(mx, 32));
    const float mn = fmaxf(m, mx), ms = (mn == -INFINITY) ? 0.f : mn;
    const float al = ex2(m - ms); m = mn;
    float ps = 0.f;
#pragma unroll
    for (int r = 0; r < 16; ++r) { s0[r] = ex2(s0[r] - ms); s1[r] = ex2(s1[r] - ms); ps += s0[r] + s1[r]; }
    l = l * al + ps;
    if (__any(al != 1.f)) {
#pragma unroll
        for (int db = 0; db < HD / 32; ++db) o[db] *= al;
    }
    bf16x8 pk[4]; p_pack(s0, s1, pk);
    if (!EARLYV) v_load<HD>(vt, vf, lane);
    pv_mma<HD>(vf, pk, o);
}
__device__ __forceinline__ void glds16(const void* gsrc, unsigned lds_dst) { unsigned keep;
    asm volatile("s_mov_b32 %0, m0\n\ts_mov_b32 m0, %2\n\ts_nop 0\n\tglobal_load_lds_dwordx4 %1, off\n\ts_mov_b32 m0, %0" : "=&s"(keep) : "v"(gsrc), "s"(lds_dst) : "memory"); }
__device__ __forceinline__ void glds4(const void* gsrc, unsigned lds_dst) { unsigned keep;
    asm volatile("s_mov_b32 %0, m0\n\ts_mov_b32 m0, %2\n\ts_nop 0\n\tglobal_load_lds_dword %1, off\n\ts_mov_b32 m0, %0" : "=&s"(keep) : "v"(gsrc), "s"(lds_dst) : "memory"); }
template <int N> __device__ __forceinline__ void wait_bar() { asm volatile("s_waitcnt vmcnt(%0) lgkmcnt(0)\n\ts_barrier" :: "n"(N) : "memory"); }
typedef float f32x2 __attribute__((ext_vector_type(2)));
__device__ __forceinline__ float fadd_s(float a, float b) { float r; asm("v_add_f32_e32 %0, %1, %2" : "=v"(r) : "v"(a), "v"(b)); return r; }
__device__ __forceinline__ float max3(float a, float b, float c) { return __builtin_fmaxf(__builtin_fmaxf(a, b), c); }
__device__ __forceinline__ float xmax32(float v) { auto rr = __builtin_amdgcn_permlane32_swap(__float_as_uint(v), __float_as_uint(v), false, false); return __builtin_fmaxf(__uint_as_float(rr[0]), __uint_as_float(rr[1])); }
constexpr float SM_THR = 16.f;
template <bool CK> __device__ __forceinline__ void qk64(const LAS unsigned char* kt, const LAS unsigned char* kx, const bf16x8 (&qf)[4], const bf16x8& qx, f32x16& s0, f32x16& s1, int lane) {
    const int r31 = lane & 31, hi = lane >> 5; const int fsw = (r31 >> 1) & 7; const LAS unsigned char* kb = kt + r31 * 128;
    bf16x8 k0[4], k1[4], kx0 = {}, kx1 = {};
#pragma unroll
    for (int ds = 0; ds < 4; ++ds) { const int off = ((2 * ds + hi) ^ fsw) << 4; k0[ds] = *(const LAS bf16x8*)(kb + off); k1[ds] = *(const LAS bf16x8*)(kb + 32 * 128 + off); }
    if (CK) { kx0 = *(const LAS bf16x8*)(kx + r31 * 32 + hi * 16); kx1 = *(const LAS bf16x8*)(kx + 1024 + r31 * 32 + hi * 16); }
    __builtin_amdgcn_s_setprio(1);
    { const f32x16 z = {}; s0 = __builtin_amdgcn_mfma_f32_32x32x16_bf16(k0[0], qf[0], z, 0, 0, 0); s1 = __builtin_amdgcn_mfma_f32_32x32x16_bf16(k1[0], qf[0], z, 0, 0, 0); }
#pragma unroll
    for (int ds = 1; ds < 4; ++ds) { s0 = __builtin_amdgcn_mfma_f32_32x32x16_bf16(k0[ds], qf[ds], s0, 0, 0, 0); s1 = __builtin_amdgcn_mfma_f32_32x32x16_bf16(k1[ds], qf[ds], s1, 0, 0, 0); }
    if (CK) { s0 = __builtin_amdgcn_mfma_f32_32x32x16_bf16(kx0, qx, s0, 0, 0, 0); s1 = __builtin_amdgcn_mfma_f32_32x32x16_bf16(kx1, qx, s1, 0, 0, 0); }
    __builtin_amdgcn_s_setprio(0);
}
__device__ __forceinline__ void pv64(const LAS unsigned char* vt, const bf16x8 (&pk)[4], f32x16 (&o)[2], int lane) { bf16x8 vf[8]; v_load<64>(vt, vf, lane); pv_mma<64>(vf, pk, o); }
template <int NDB, class F> __device__ __forceinline__ bool smx(f32x16& s0, f32x16& s1, bf16x8 (&pk)[4], f32x16 (&o)[NDB], float& R, f32x2& l2, int& init, const F& f, int j, int lane) {
    const int hi = lane >> 5;
    const bool ok = f.lane_ok(j);
    if (f.needmask(j)) f.mask(s0, s1, j, hi);
    if (__any(R != 0.f)) { s0 -= R; s1 -= R; }
    float a = max3(s0[0], s0[1], s1[0]), b = max3(s0[2], s0[3], s1[1]); a = max3(a, s1[2], s1[3]);
#pragma unroll
    for (int r = 4; r < 16; r += 4) { a = max3(a, s0[r], s0[r + 1]); b = max3(b, s0[r + 2], s0[r + 3]); a = max3(a, s1[r], s1[r + 1]); b = max3(b, s1[r + 2], s1[r + 3]); }
    float rm = xmax32(__builtin_fmaxf(a, b));
    if (!ok) rm = -INFINITY;
    const bool fin = rm > -INFINITY;
    if (__all(rm < -140.f && (init || !fin))) return false;
    const bool need = (rm > SM_THR) || (!init && fin && rm < -SM_THR);
    if (__any(need)) {
        const float d = need ? rm : 0.f; R += d; s0 -= d; s1 -= d;
        const float fs = (need && init) ? ex2(-d) : 1.f; l2 *= fs;
#pragma unroll
        for (int db = 0; db < NDB; ++db) o[db] *= fs;
    }
    init |= fin ? 1 : 0;
#pragma unroll
    for (int r = 0; r < 16; ++r) { s0[r] = ex2(s0[r]); s1[r] = ex2(s1[r]); }
    f32x2 acc;
    { float a0 = fadd_s(s0[0], s0[1]), a1 = fadd_s(s1[0], s1[1]), a2 = fadd_s(s0[2], s0[3]), a3 = fadd_s(s1[2], s1[3]);
#pragma unroll
      for (int r = 4; r < 16; r += 4) { a0 = fadd_s(a0, s0[r]); a1 = fadd_s(a1, s1[r]); a2 = fadd_s(a2, s0[r + 1]); a3 = fadd_s(a3, s1[r + 1]); a0 = fadd_s(a0, s0[r + 2]); a1 = fadd_s(a1, s1[r + 2]); a2 = fadd_s(a2, s0[r + 3]); a3 = fadd_s(a3, s1[r + 3]); }
      acc.x = fadd_s(a0, a1); acc.y = fadd_s(a2, a3); }
    p_pack(s0, s1, pk);
    if (__any(!ok)) {
        const bf16x8 zz = {};
#pragma unroll
        for (int i = 0; i < 4; ++i) pk[i] = ok ? pk[i] : zz;
        acc = ok ? acc : (f32x2){0.f, 0.f};
    }
    l2 += acc;
    return true;
}
__device__ __forceinline__ void bar_lds() { asm volatile("s_waitcnt lgkmcnt(0)\n\ts_barrier" ::: "memory"); }
template <bool CK, bool DESC, class F>
__device__ __forceinline__ void attn_run64(LAS unsigned char* lds, const bf16* Kg, int ldk, const bf16* Vg, int ldv, const bf16* kxg, const bf16x8& qx, unsigned tmask,
                                           const bf16x8 (&qf)[4], f32x16 (&o)[2], float& l, const F& f, int tid, int lane) {
    l = 0.f;
    if (tmask == 0u) return;
    constexpr int NB = 5, LPT = 2 + (CK ? 1 : 0), TILEB = AT<64>::TILEB, BUFB = AT<64>::BUFB, CKOFF = AT<64>::CKOFF;
    const int wid = __builtin_amdgcn_readfirstlane(tid >> 6);
    const unsigned lds0 = (unsigned)(size_t)lds;
    const int r = 8 * wid + (lane >> 3), pc = lane & 7;
    const int koff = r * ldk + ((pc ^ AT<64>::fk(r)) << 3), voff = r * ldv + (((((pc >> 2) ^ AT<64>::fv(r)) << 2) | (pc & 3)) << 3);
    unsigned remi = tmask; int lastj = 0, ib = 0;
#define ATTN_ISSUE() do { \
        if (remi) { if (DESC) { lastj = 31 - __builtin_clz(remi); remi &= ~(1u << lastj); } else { lastj = __builtin_ctz(remi); remi &= remi - 1; } } \
        const unsigned kdst_ = lds0 + ib * BUFB + wid * 1024; \
        glds16(Kg + (size_t)(64 * lastj) * ldk + koff, (unsigned)__builtin_amdgcn_readfirstlane(kdst_)); \
        glds16(Vg + (size_t)(64 * lastj) * ldv + voff, (unsigned)__builtin_amdgcn_readfirstlane(kdst_ + TILEB)); \
        if (CK) glds4((const unsigned char*)kxg + (size_t)(64 * lastj) * 32 + wid * 256 + lane * 4, (unsigned)__builtin_amdgcn_readfirstlane(lds0 + CKOFF + ib * 2048 + wid * 256)); \
        ib = ib + 1 == NB ? 0 : ib + 1; } while (0)
    ATTN_ISSUE(); ATTN_ISSUE(); ATTN_ISSUE(); ATTN_ISSUE();
    unsigned remq = tmask; int cb = 0, jc = 0;
    float R = 0.f; f32x2 l2 = {0.f, 0.f}; int init = 0;
    while (remq) {
        wait_bar<3 * LPT>();
        ATTN_ISSUE();
        if (DESC) { jc = 31 - __builtin_clz(remq); remq &= ~(1u << jc); } else { jc = __builtin_ctz(remq); remq &= remq - 1; }
        if (f.active(jc)) {
            f32x16 s0, s1; bf16x8 pk[4], vf[8];
            qk64<CK>(lds + cb * BUFB, lds + CKOFF + cb * 2048, qf, qx, s0, s1, lane);
            v_load<64>(lds + cb * BUFB + TILEB, vf, lane);
            if (smx<2>(s0, s1, pk, o, R, l2, init, f, jc, lane)) pv_mma<64>(vf, pk, o);
        }
        cb = cb + 1 == NB ? 0 : cb + 1;
    }
    wait_bar<0>();
    l = l2.x + l2.y;
#undef ATTN_ISSUE
}
template <int HD, class F>
__device__ __forceinline__ void attn_run128(LAS unsigned char* lds, const bf16* Kg, int ldk, const bf16* Vg, int ldv, unsigned tmask,
                                            const bf16x8 (&qf)[HD / 16], f32x16 (&o)[HD / 32], float& l, const F& f, int tid, int lane) {
    l = 0.f;
    if (tmask == 0u) return;
    constexpr int NB = AT<HD>::NB, D = AT<HD>::DEPTH, PPW = HD / 64, LPT = 2 * PPW;
    const int wid = __builtin_amdgcn_readfirstlane(tid >> 6);
    const unsigned lds0 = (unsigned)(size_t)lds;
    int koff[PPW], voff[PPW];
#pragma unroll
    for (int p = 0; p < PPW; ++p) { const int piece = wid * PPW + p; const int r = 4 * piece + (lane >> 4); const int pc = lane & 15;
        koff[p] = r * ldk + ((pc ^ AT<HD>::fk(r)) << 3); const int blk = (pc >> 2) ^ AT<HD>::fv(r); voff[p] = r * ldv + (((blk << 2) | (pc & 3)) << 3); }
    unsigned remi = tmask; int lastj = 0, ib = 0;
#define ATTN_ISSUE() do { \
        if (remi) { lastj = __builtin_ctz(remi); remi &= remi - 1; } \
        const unsigned kdst_ = lds0 + ib * AT<HD>::BUFB + wid * PPW * 1024, vdst_ = kdst_ + AT<HD>::TILEB; \
        _Pragma("unroll") for (int p = 0; p < PPW; ++p) { glds16(Kg + (size_t)(64 * lastj) * ldk + koff[p], (unsigned)__builtin_amdgcn_readfirstlane(kdst_ + p * 1024)); \
            glds16(Vg + (size_t)(64 * lastj) * ldv + voff[p], (unsigned)__builtin_amdgcn_readfirstlane(vdst_ + p * 1024)); } \
        ib = ib + 1 == NB ? 0 : ib + 1; } while (0)
#pragma unroll
    for (int k = 0; k < D; ++k) ATTN_ISSUE();
    unsigned remp = tmask; int pb = 0; float R = 0.f; f32x2 l2 = {0.f, 0.f}; int init = 0;
    while (remp) {
        wait_bar<(D - 1) * LPT>();
        ATTN_ISSUE();
        const int j = __builtin_ctz(remp); remp &= remp - 1;
        if (f.active(j)) { const LAS unsigned char* kt = lds + pb * AT<HD>::BUFB; f32x16 s0 = {}, s1 = {}; bf16x8 pk[4]; qk_tile<HD>(kt, qf, s0, s1, lane);
            if (smx<HD / 32>(s0, s1, pk, o, R, l2, init, f, j, lane)) { bf16x8 vf[HD / 8]; v_load<HD>(kt + AT<HD>::TILEB, vf, lane); pv_mma<HD>(vf, pk, o); } }
        pb = pb + 1 == NB ? 0 : pb + 1;
    }
    wait_bar<0>();
    l = l2.x + l2.y;
#undef ATTN_ISSUE
}
template <int HD> __device__ __forceinline__ void attn_store(LAS unsigned char* stg, const f32x16 (&o)[HD / 32], const bf16* zg, int ldz, bf16* outg, int ldo, int lane) {
    const int q = lane & 31, hi = lane >> 5;
#pragma unroll
    for (int db = 0; db < HD / 32; ++db)
#pragma unroll
        for (int g = 0; g < 4; ++g) { u32x2 w; w.x = cvtpk(o[db][4 * g], o[db][4 * g + 1]); w.y = cvtpk(o[db][4 * g + 2], o[db][4 * g + 3]);
            *(LAS u32x2*)(stg + q * AT<HD>::STGROW + (32 * db + 8 * g + 4 * hi) * 2) = w; }
    constexpr int CPR = AT<HD>::CPR, RPP = 64 / CPR, NIT = 32 / RPP;
    u32x4 zs[NIT];
#pragma unroll
    for (int it = 0; it < NIT; ++it) { const int row = it * RPP + lane / CPR, ch = lane % CPR; zs[it] = *(const u32x4*)(zg + (size_t)row * ldz + ch * 8); }
#pragma unroll
    for (int it = 0; it < NIT; ++it) { const int row = it * RPP + lane / CPR, ch = lane % CPR;
        const u32x4 v = *(const LAS u32x4*)(stg + row * AT<HD>::STGROW + ch * 16); const u32x4 z = zs[it];
        u32x4 w; w.x = cvtpk(bflo(v.x) * silu_f(bflo(z.x)), bfhi(v.x) * silu_f(bfhi(z.x))); w.y = cvtpk(bflo(v.y) * silu_f(bflo(z.y)), bfhi(v.y) * silu_f(bfhi(z.y)));
        w.z = cvtpk(bflo(v.z) * silu_f(bflo(z.z)), bfhi(v.z) * silu_f(bfhi(z.z))); w.w = cvtpk(bflo(v.w) * silu_f(bflo(z.w)), bfhi(v.w) * silu_f(bfhi(z.w)));
        *(u32x4*)(outg + (size_t)row * ldo + ch * 8) = w; }
}
template <int HD> __device__ __forceinline__ void load_q(const bf16* qrow, bf16x8 (&qf)[HD / 16], int hi) {
#pragma unroll
    for (int ds = 0; ds < HD / 16; ++ds) qf[ds] = *(const bf16x8*)(qrow + 16 * ds + 8 * hi);
}
__device__ __forceinline__ float lsum_inv(float l) { const float lt = l + __shfl_xor(l, 32); return lt > 0.f ? 1.f / lt : 0.f; }

struct FNone { __device__ __forceinline__ bool active(int) const { return true; } __device__ __forceinline__ bool lane_ok(int) const { return true; } __device__ __forceinline__ bool needmask(int) const { return false; }
    __device__ __forceinline__ void mask(f32x16&, f32x16&, int, int) const {} };
struct FForget {
    int tq, qmin, qmax;
    __device__ __forceinline__ bool active(int j) const { return 64 * j <= qmax; }
    __device__ __forceinline__ bool lane_ok(int) const { return true; }
    __device__ __forceinline__ bool needmask(int j) const { return 64 * j + 63 > qmin; }
    __device__ __forceinline__ void mask(f32x16& s0, f32x16& s1, int j, int hi) const {
        const int kb = 64 * j;
#pragma unroll
        for (int r = 0; r < 16; ++r) { const int k0 = kb + crow(r, hi); if (k0 > tq) s0[r] = -INFINITY; if (k0 + 32 > tq) s1[r] = -INFINITY; }
    }
};
struct FSelWin {
    unsigned sel; int tq, cur, mode, lo;
    __device__ __forceinline__ bool active(int j) const { return mode ? true : (__any((sel >> j) & 1u) != 0); }
    __device__ __forceinline__ bool lane_ok(int j) const { return mode ? true : (((sel >> j) & 1u) != 0u); }
    __device__ __forceinline__ bool needmask(int j) const { return (j == cur) || (mode && j == cur - 4); }
    __device__ __forceinline__ void mask(f32x16& s0, f32x16& s1, int j, int hi) const {
        const int kb = 64 * j;
#pragma unroll
        for (int r = 0; r < 16; ++r) { const int k0 = kb + crow(r, hi); if (k0 > tq || k0 <= lo) s0[r] = -INFINITY; if (k0 + 32 > tq || k0 + 32 <= lo) s1[r] = -INFINITY; }
    }
};

struct Ptrs {
    const float* in[21]; unsigned char* out; unsigned char* ws;
};
__device__ __forceinline__ void fa_item(const Ptrs& P, LAS unsigned char* lds, int b, int h, int qt, int tid, int lane, int wid, int dry) {
    bf16* CQ = (bf16*)slot_ptr(P.ws, P.out, SL_CQ); const bf16* CK = (const bf16*)slot_ptr(P.ws, P.out, SL_CK); const bf16* CV = (const bf16*)slot_ptr(P.ws, P.out, SL_CV); const bf16* CZ = (const bf16*)slot_ptr(P.ws, P.out, SL_CZ);
    const bf16* KX = (const bf16*)(P.ws + WS_KX) + (size_t)(b * 8 + h) * SEQ * 16; const bf16* QX = (const bf16*)(P.ws + WS_QX) + (size_t)(b * 8 + h) * SEQ * 8;
    const int hi = lane >> 5, t0 = 256 * qt + 32 * wid, tq = t0 + (lane & 31);
    const size_t rowq = (size_t)(b * SEQ + tq) * 512 + h * 64;
    bf16x8 qf[4]; load_q<64>(CQ + rowq, qf, hi);
    f32x16 o[2] = {}; float l = 0.f;
    bf16x8 qx = {}; if (hi == 0) qx = *(const bf16x8*)(QX + (size_t)tq * 8);
    FForget f; f.tq = tq; f.qmin = t0; f.qmax = t0 + 31;
    const int ntile = 4 * qt + 4; const unsigned tmask = ntile >= 32 ? 0xffffffffu : ((1u << ntile) - 1u);
    attn_run64<true, true>(lds, CK + (size_t)b * SEQ * 512 + h * 64, 512, CV + (size_t)b * SEQ * 512 + h * 64, 512, KX, qx, tmask, qf, o, l, f, tid, lane);
    const float li = lsum_inv(l);
    o[0] *= li; o[1] *= li;
    const size_t row0 = (size_t)(b * SEQ + t0) * 512 + h * 64;
    if (!dry) attn_store<64>(lds + AT<64>::STGOFF + wid * AT<64>::STGB, o, CZ + row0, 512, CQ + row0, 512, lane);
    else asm volatile("" :: "v"(o[0][0]), "v"(o[1][0]));
}
__device__ __forceinline__ void mem_item(const Ptrs& P, LAS unsigned char* lds, int b, int h, int qt, int tid, int lane, int wid, int dry) {
    bf16* MQ = (bf16*)slot_ptr(P.ws, P.out, SL_MQ); const bf16* MZ = (const bf16*)slot_ptr(P.ws, P.out, SL_MZ); const bf16* MKV = (const bf16*)(P.ws + WS_MKV);
    const int hi = lane >> 5, t0 = 256 * qt + 32 * wid, tq = t0 + (lane & 31);
    bf16x8 qf[8]; load_q<128>(MQ + (size_t)(b * SEQ + tq) * 512 + h * 128, qf, hi);
    f32x16 o[4] = {}; float l = 0.f; FNone f; const bf16x8 qx0 = {};
    attn_run128<128>(lds, MKV + (size_t)b * MEMLEN * 1024 + h * 128, 1024, MKV + (size_t)b * MEMLEN * 1024 + 512 + h * 128, 1024, 0xfu, qf, o, l, f, tid, lane);
    const float li = lsum_inv(l);
#pragma unroll
    for (int db = 0; db < 4; ++db) o[db] *= li;
    const size_t row0 = (size_t)(b * SEQ + t0) * 512 + h * 128;
    if (!dry) attn_store<128>(lds + AT<128>::STGOFF + wid * AT<128>::STGB, o, MZ + row0, 512, MQ + row0, 512, lane);
    else asm volatile("" :: "v"(o[0][0]), "v"(o[1][0]), "v"(o[2][0]), "v"(o[3][0]));
}
constexpr int NSA_IMPQ = 32768;
constexpr int NSA_IMPL = NSA_IMPQ + 32768;
constexpr int NSA_IMPF = NSA_IMPL + 32768;
constexpr int NSA_SEL = NSA_IMPF + 8192;
__device__ __forceinline__ void nsa_item(const Ptrs& P, LAS unsigned char* lds, int b, int kvh, int cur, int tid, int lane, int wid, int dry) {
    bf16* BQ = (bf16*)slot_ptr(P.ws, P.out, SL_BQ); const bf16* BZ = (const bf16*)slot_ptr(P.ws, P.out, SL_BZ);
    const bf16* KVS = (const bf16*)(P.ws + WS_KVS); const size_t hoff = (size_t)(b * 2 + kvh) * SEQ * 64;
    const bf16* KS = KVS + 1 * 2 * MiB + hoff; const bf16* KW = KVS + 2 * 2 * MiB + hoff; const bf16* VS = KVS + 4 * 2 * MiB + hoff; const bf16* VW = KVS + 5 * 2 * MiB + hoff;
    const bf16* KCMP = (const bf16*)(P.ws + WS_KCMP) + (size_t)(b * 2 + kvh) * 128 * 64; const bf16* VCMP = (const bf16*)(P.ws + WS_VCMP) + (size_t)(b * 2 + kvh) * 128 * 64;
    const float* SM = (const float*)(P.ws + WS_SM);
    const int hi = lane >> 5, g = wid >> 1, pos = 32 * (wid & 1) + (lane & 31), tq = 64 * cur + pos, hq = kvh * 4 + g;
    const size_t rowq = (size_t)(b * SEQ + tq) * 512 + hq * 64;
    bf16x8 qf[4]; load_q<64>(BQ + rowq, qf, hi);
    const float* gl = SM + (size_t)(b * SEQ + tq) * 32 + hq * 3; const float g0 = gl[0], g12[2] = {gl[1], gl[2]};
    f32x16 res[2] = {};
    {
        const int ntc = (4 * cur + 2) / 64 + 1;
        u32x4 kr[2][1], vr[2][1];
#pragma unroll
        for (int tl = 0; tl < 2; ++tl) if (tl < ntc) { tile_load<64>(KCMP, 64, 64 * tl, kr[tl], tid); tile_load<64>(VCMP, 64, 64 * tl, vr[tl], tid); }
#pragma unroll
        for (int tl = 0; tl < 2; ++tl) if (tl < ntc) { tile_store_k<64>(lds + tl * AT<64>::BUFB, kr[tl], tid); tile_store_v<64>(lds + tl * AT<64>::BUFB + AT<64>::TILEB, vr[tl], tid); }
        __syncthreads();
        f32x16 o[2] = {}; float m = -INFINITY, l = 0.f;
#pragma unroll 1
        for (int tl = 0; tl < ntc; ++tl) {
            f32x16 s0 = {}, s1 = {};
            qk_tile<64>(lds + tl * AT<64>::BUFB, qf, s0, s1, lane);
#pragma unroll
            for (int r = 0; r < 16; ++r) { const int c0 = 64 * tl + crow(r, hi); if (16 * c0 + 31 > tq) s0[r] = -INFINITY; if (16 * (c0 + 32) + 31 > tq) s1[r] = -INFINITY; }
            softmax_pv<64, true>(lds + tl * AT<64>::BUFB + AT<64>::TILEB, s0, s1, o, m, l, lane);
        }
        const float li = lsum_inv(l), ms = (m == -INFINITY) ? 0.f : m;
        res[0] = o[0] * (g0 * li); res[1] = o[1] * (g0 * li);
        LAS float* impq = (LAS float*)(lds + NSA_IMPQ) + g * 2048 + pos; LAS float* impl = (LAS float*)(lds + NSA_IMPL) + g * 2048 + pos;
#pragma unroll 1
        for (int tl = 0; tl < 2; ++tl) {
            f32x16 s0 = {}, s1 = {};
            if (tl < ntc) { qk_tile<64>(lds + tl * AT<64>::BUFB, qf, s0, s1, lane);
#pragma unroll
                for (int r = 0; r < 16; ++r) { const int c0 = 64 * tl + crow(r, hi); s0[r] = (16 * c0 + 31 > tq) ? 0.f : ex2(s0[r] - ms) * li; s1[r] = (16 * (c0 + 32) + 31 > tq) ? 0.f : ex2(s1[r] - ms) * li; } }
#pragma unroll
            for (int gq = 0; gq < 4; ++gq) { const int j0 = 16 * tl + 2 * gq + hi;
                impq[j0 * 64] = (s0[4 * gq] + s0[4 * gq + 1]) + (s0[4 * gq + 2] + s0[4 * gq + 3]); impl[j0 * 64] = s0[4 * gq + 3];
                impq[(j0 + 8) * 64] = (s1[4 * gq] + s1[4 * gq + 1]) + (s1[4 * gq + 2] + s1[4 * gq + 3]); impl[(j0 + 8) * 64] = s1[4 * gq + 3]; }
        }
    }
    __syncthreads();
    {
        const int p = tid >> 3, sub = tid & 7; const int e0 = p * 32 + 4 * sub;
        const LAS float* bq = (const LAS float*)(lds + NSA_IMPQ) + (4 * sub) * 64 + p; const LAS float* bl = (const LAS float*)(lds + NSA_IMPL) + (4 * sub) * 64 + p; LAS float* impf = (LAS float*)(lds + NSA_IMPF) + e0;
        float v[4] = {0.f, 0.f, 0.f, 0.f};
#pragma unroll
        for (int gg = 0; gg < 4; ++gg) { const float cm1 = sub > 0 ? bl[gg * 2048 - 64] : 0.f;
            v[0] += bq[gg * 2048] + cm1; v[1] += bq[gg * 2048 + 64] + bl[gg * 2048]; v[2] += bq[gg * 2048 + 128] + bl[gg * 2048 + 64]; v[3] += bq[gg * 2048 + 192] + bl[gg * 2048 + 128]; }
#pragma unroll
        for (int i = 0; i < 4; ++i) { const int j = 4 * sub + i; if (j == 0 || j == cur || j == cur - 1) v[i] = 1e9f; else if (j > cur) v[i] = -1e30f; }
        *(LAS f32x4*)impf = (f32x4){v[0], v[1], v[2], v[3]};
    }
    __syncthreads();
    {
        const int p = tid >> 3, sub = tid & 7; LAS float* impf = (LAS float*)(lds + NSA_IMPF) + p * 32; LAS unsigned* selw = (LAS unsigned*)(lds + NSA_SEL);
        float mine[4]; int rank[4] = {0, 0, 0, 0};
#pragma unroll
        for (int i = 0; i < 4; ++i) mine[i] = impf[4 * sub + i];
        for (int jj = 0; jj < 32; ++jj) { const float v = impf[jj];
#pragma unroll
            for (int i = 0; i < 4; ++i) { const int j = 4 * sub + i; rank[i] += (v > mine[i] || (v == mine[i] && jj < j)) ? 1 : 0; } }
        unsigned bits = 0u;
#pragma unroll
        for (int i = 0; i < 4; ++i) { const int j = 4 * sub + i; if (rank[i] < 8 && j <= cur) bits |= 1u << j; }
        bits |= __shfl_xor(bits, 1); bits |= __shfl_xor(bits, 2); bits |= __shfl_xor(bits, 4);
        if (sub == 0) selw[p] = bits;
    }
    __syncthreads();
    unsigned selm, uni;
    {
        LAS unsigned* selw = (LAS unsigned*)(lds + NSA_SEL);
        selm = selw[pos];
        unsigned u = selw[lane];
#pragma unroll
        for (int o = 1; o < 64; o <<= 1) u |= __shfl_xor(u, o);
        uni = __builtin_amdgcn_readfirstlane(u);
    }
    const int j0w = cur >= 4 ? cur - 4 : 0; const unsigned hiM = cur >= 31 ? 0xffffffffu : ((2u << cur) - 1u); const unsigned wmask = hiM & ~((1u << j0w) - 1u);
#pragma unroll 1
    for (int br = 0; br < 2; ++br) {
        if (dry >= 8 && ((dry == 8) || (dry == 9 && br == 1) || (dry == 10 && br == 0))) continue;
        f32x16 o[2] = {}; float l = 0.f; FSelWin f; f.sel = selm; f.tq = tq; f.cur = cur; f.mode = br; f.lo = br ? tq - 256 : -1; const bf16x8 qx0 = {};
        attn_run64<false, false>(lds, br ? KW : KS, 64, br ? VW : VS, 64, nullptr, qx0, br ? wmask : uni, qf, o, l, f, tid, lane);
        const float li = lsum_inv(l) * (br ? g12[1] : g12[0]); res[0] += o[0] * li; res[1] += o[1] * li;
    }
    const size_t row0 = (size_t)(b * SEQ + 64 * cur + 32 * (wid & 1)) * 512 + hq * 64;
    if (!dry) attn_store<64>(lds + AT<64>::STGOFF + wid * AT<64>::STGB, res, BZ + row0, 512, BQ + row0, 512, lane);
    else asm volatile("" :: "v"(res[0][0]), "v"(res[1][0]));
    __syncthreads();
}
__device__ __forceinline__ void cmp_item(const Ptrs& P, LAS unsigned char* lds, int layer, int b, int kvh, int which, int rq, int lane, int wid) {
    const bf16* W = (const bf16*)wbase(P.ws, P.out, layer);
    const bf16* A = (const bf16*)(P.ws + WS_KVS) + (size_t)(which ? 3 : 0) * 2 * MiB + (size_t)(b * 2 + kvh) * SEQ * 64;
    const bf16* W1 = (const bf16*)((const unsigned char*)W + (which ? W_1V : W_1K)); const bf16* W2 = (const bf16*)((const unsigned char*)W + (which ? W_2V : W_2K));
    const float* bias1 = (const float*)(P.ws + WS_BIAS1) + which * 64;
    bf16* O = (bf16*)(P.ws + (which ? WS_VCMP : WS_KCMP)) + (size_t)(b * 2 + kvh) * 128 * 64;
    const int rt = wid & 1, k4 = wid >> 1, c = 32 * rq + 16 * rt + (lane & 15), kq = lane >> 4;
    f32x4 acc[4] = {};
    const bf16* ap = A + (size_t)c * 1024 + 8 * kq + 512 * k4; const bf16* wp = W1 + (size_t)(lane & 15) * 2048 + 8 * kq + 512 * k4;
#pragma unroll 4
    for (int ks = 0; ks < 16; ++ks) {
        const bf16x8 af = *(const bf16x8*)(ap + 32 * ks);
#pragma unroll
        for (int et = 0; et < 4; ++et) { const bf16x8 wf = *(const bf16x8*)(wp + (size_t)et * 16 * 2048 + 32 * ks); acc[et] = __builtin_amdgcn_mfma_f32_16x16x32_bf16(wf, af, acc[et], 0, 0, 0); }
    }
    LAS float* part = (LAS float*)lds + ((k4 * 2 + rt) * 64 + lane) * 16;
#pragma unroll
    for (int et = 0; et < 4; ++et) *(LAS f32x4*)(part + 4 * et) = acc[et];
    __syncthreads();
    if (k4 == 0) {
#pragma unroll
        for (int kk = 1; kk < 4; ++kk)
#pragma unroll
            for (int et = 0; et < 4; ++et) acc[et] += *(const LAS f32x4*)(part + kk * 2 * 64 * 16 + 4 * et);
        bf16x8 hf[2];
#pragma unroll
        for (int s = 0; s < 2; ++s) { u32x4 w; float v[8];
#pragma unroll
            for (int i = 0; i < 4; ++i) { v[i] = silu_f(acc[2 * s][i] + bias1[32 * s + 4 * kq + i]); v[4 + i] = silu_f(acc[2 * s + 1][i] + bias1[32 * s + 16 + 4 * kq + i]); }
            w.x = cvtpk(v[0], v[1]); w.y = cvtpk(v[2], v[3]); w.z = cvtpk(v[4], v[5]); w.w = cvtpk(v[6], v[7]); hf[s] = __builtin_bit_cast(bf16x8, w); }
        f32x4 o2[4] = {};
#pragma unroll
        for (int et = 0; et < 4; ++et)
#pragma unroll
            for (int s = 0; s < 2; ++s) { const bf16* w2r = W2 + (size_t)(16 * et + (lane & 15)) * 64 + 32 * s + 4 * kq;
                const u32x2 a = *(const u32x2*)w2r, bq = *(const u32x2*)(w2r + 16); u32x4 w; w.x = a.x; w.y = a.y; w.z = bq.x; w.w = bq.y;
                o2[et] = __builtin_amdgcn_mfma_f32_16x16x32_bf16(__builtin_bit_cast(bf16x8, w), hf[s], o2[et], 0, 0, 0); }
#pragma unroll
        for (int et = 0; et < 4; ++et) { u32x2 w; w.x = cvtpk(o2[et][0], o2[et][1]); w.y = cvtpk(o2[et][2], o2[et][3]); if (c == 127) { w.x = 0u; w.y = 0u; }
            *(u32x2*)(O + (size_t)c * 64 + 16 * et + 4 * kq) = w; }
    }
}
constexpr int GM_ROWB = 1024 + 16;
__device__ __forceinline__ void gmlp_item(const Ptrs& P, LAS unsigned char* lds, int layer, int b, int ch, int tid, int lane, int wid, int dry) {
    bf16* U = (bf16*)slot_ptr(P.ws, P.out, SL_U); const bf16* V = (const bf16*)slot_ptr(P.ws, P.out, SL_V); const bf16* AZ = (const bf16*)slot_ptr(P.ws, P.out, SL_AZ);
    const bf16* WSP = (const bf16*)(wbase(P.ws, P.out, layer) + W_WS); const float* lng = P.in[7] + layer * 512; const float* lnb = P.in[8] + layer * 512; const float* bs = P.in[10] + layer * 512;
    const size_t r0 = (size_t)b * SEQ + 128 * ch;
    {
        float gam[8], bet[8];
#pragma unroll
        for (int i = 0; i < 8; ++i) { gam[i] = lng[8 * lane + i]; bet[i] = lnb[8 * lane + i]; }
        u32x4 raws[16];
#pragma unroll
        for (int rr = 0; rr < 16; ++rr) raws[rr] = *(const u32x4*)(V + (r0 + 16 * wid + rr) * 512 + 8 * lane);
        float s1[16], s2[16];
#pragma unroll
        for (int rr = 0; rr < 16; ++rr) { const u32x4 raw = raws[rr]; const float x[8] = {bflo(raw.x), bfhi(raw.x), bflo(raw.y), bfhi(raw.y), bflo(raw.z), bfhi(raw.z), bflo(raw.w), bfhi(raw.w)};
            float a = 0.f, q = 0.f;
#pragma unroll
            for (int i = 0; i < 8; ++i) { a += x[i]; q += x[i] * x[i]; }
            s1[rr] = a; s2[rr] = q; }
#pragma unroll
        for (int o = 1; o < 64; o <<= 1) {
#pragma unroll
            for (int rr = 0; rr < 16; ++rr) { s1[rr] += __shfl_xor(s1[rr], o); s2[rr] += __shfl_xor(s2[rr], o); }
        }
#pragma unroll
        for (int rr = 0; rr < 16; ++rr) { const int row = 16 * wid + rr; const u32x4 raw = raws[rr];
            const float x[8] = {bflo(raw.x), bfhi(raw.x), bflo(raw.y), bfhi(raw.y), bflo(raw.z), bfhi(raw.z), bflo(raw.w), bfhi(raw.w)};
            const float mu = s1[rr] * (1.f / 512.f); const float var = fmaxf(s2[rr] * (1.f / 512.f) - mu * mu, 0.f); const float rstd = 1.f / sqrtf(var + EPS);
            float y[8];
#pragma unroll
            for (int i = 0; i < 8; ++i) y[i] = (x[i] - mu) * rstd * gam[i] + bet[i];
            u32x4 w; w.x = cvtpk(y[0], y[1]); w.y = cvtpk(y[2], y[3]); w.z = cvtpk(y[4], y[5]); w.w = cvtpk(y[6], y[7]);
            *(LAS u32x4*)(lds + row * GM_ROWB + 16 * lane) = w; }
    }
    __syncthreads();
    const int tl = lane & 15, kq = lane >> 4, t = 16 * wid + tl; const int nks = (16 * wid + 15) / 32 + 1;
    const LAS unsigned char* vb = lds + (8 * kq + ((lane >> 2) & 3)) * GM_ROWB + 8 * (lane & 3);
    for (int g = 0; g < 4; ++g) {
        f32x4 acc[8] = {};
        const bf16* wrow = WSP + (size_t)(g * 128 + t) * 128 + 8 * kq;
        bf16x8 wfs[4];
#pragma unroll
        for (int ks = 0; ks < 4; ++ks) wfs[ks] = *(const bf16x8*)(wrow + 32 * (ks < nks ? ks : 0));
        u32x2 uus[8], zzs[8];
#pragma unroll
        for (int dt = 0; dt < 8; ++dt) { const size_t off = (r0 + t) * 512 + g * 128 + 16 * dt + 4 * kq; uus[dt] = *(const u32x2*)(U + off); zzs[dt] = *(const u32x2*)(AZ + off); }
        const float bsv = bs[g * 128 + t];
#pragma unroll
        for (int ks = 0; ks < 4; ++ks) {
            if (ks < nks) {
                const bf16x8 wf = wfs[ks];
#pragma unroll
                for (int dt = 0; dt < 8; ++dt) { const LAS unsigned char* p = vb + (32 * ks) * GM_ROWB + (g * 128 + 16 * dt) * 2;
                    const s16x4 lo = vtr(p), hh = vtr(p + 4 * GM_ROWB); const bf16x8 vf = (bf16x8){lo[0], lo[1], lo[2], lo[3], hh[0], hh[1], hh[2], hh[3]};
                    acc[dt] = __builtin_amdgcn_mfma_f32_16x16x32_bf16(vf, wf, acc[dt], 0, 0, 0); }
            }
        }
#pragma unroll
        for (int dt = 0; dt < 8; ++dt) { const size_t off = (r0 + t) * 512 + g * 128 + 16 * dt + 4 * kq; const u32x2 uu = uus[dt], zz = zzs[dt];
            u32x2 w; w.x = cvtpk((acc[dt][0] + bsv) * gelu_f(bflo(uu.x)) * silu_f(bflo(zz.x)), (acc[dt][1] + bsv) * gelu_f(bfhi(uu.x)) * silu_f(bfhi(zz.x))); w.y = cvtpk((acc[dt][2] + bsv) * gelu_f(bflo(uu.y)) * silu_f(bflo(zz.y)), (acc[dt][3] + bsv) * gelu_f(bfhi(uu.y)) * silu_f(bfhi(zz.y)));
            if (!dry) *(u32x2*)(U + off) = w; else asm volatile("" :: "v"(w.x), "v"(w.y)); }
    }
    __syncthreads();
}
__device__ __forceinline__ void cumsum_item(const Ptrs& P, LAS unsigned char* lds, int b, int h, int tid, int lane, int wid) {
    const float* SM = (const float*)(P.ws + WS_SM) + ((size_t)b * SEQ + 4 * tid) * 32 + 24 + h;
    bf16* KX = (bf16*)(P.ws + WS_KX) + ((size_t)(b * 8 + h) * SEQ + 4 * tid) * 16; bf16* QX = (bf16*)(P.ws + WS_QX) + ((size_t)(b * 8 + h) * SEQ + 4 * tid) * 8;
    LAS float* wsum = (LAS float*)(lds + LDS_MISC + 64);
    float v[4];
#pragma unroll
    for (int i = 0; i < 4; ++i) v[i] = SM[(size_t)i * 32];
    v[1] += v[0]; v[2] += v[1]; v[3] += v[2];
    float tot = v[3];
#pragma unroll
    for (int o = 1; o < 64; o <<= 1) { const float x = __shfl_up(tot, o); if (lane >= o) tot += x; }
    if (lane == 63) wsum[wid] = tot;
    __syncthreads();
    float base = tot - v[3];
    for (int w = 0; w < wid; ++w) base += wsum[w];
#pragma unroll
    for (int i = 0; i < 4; ++i) { const float c = v[i] + base;
        const unsigned h0 = cvtpk(c, 0.f) & 0xffffu; const float r1 = c - __uint_as_float(h0 << 16);
        const unsigned h1 = cvtpk(r1, 0.f) & 0xffffu; const float r2 = r1 - __uint_as_float(h1 << 16);
        const unsigned h2 = cvtpk(r2, 0.f) & 0xffffu;
        const unsigned ONE = 0x3f80u;
        u32x4 q; q.x = ONE | (ONE << 16); q.y = ONE | (h0 << 16); q.z = h1 | (h2 << 16); q.w = 0u;
        *(u32x4*)(QX + i * 8) = q;
        u32x4 k; k.x = (h0 ^ 0x8000u) | ((h1 ^ 0x8000u) << 16); k.y = (h2 ^ 0x8000u) | (ONE << 16); k.z = ONE | (ONE << 16); k.w = 0u;
        *(u32x4*)(KX + i * 16) = k; *(u32x4*)(KX + i * 16 + 8) = (u32x4){0u, 0u, 0u, 0u}; }
}

__device__ __forceinline__ void prep_item(const float* W, int K, int Nsrc, const float* scale, bf16* out, int row_off, int P, bool projmap, LAS float* scr, int item, int lane) {
    const int nblk = P / 32, kb = item / nblk, nb = item % nblk, k0 = 64 * kb, n0 = 32 * nb;
    const int p = n0 + (lane & 31); const int src = projmap ? proj_src(p) : p;
    float wv[32];
#pragma unroll
    for (int i = 0; i < 32; ++i) { const int kk = 2 * i + (lane >> 5); wv[i] = src >= 0 ? W[(size_t)(k0 + kk) * Nsrc + src] : 0.f; }
    if (scale) {
#pragma unroll
        for (int i = 0; i < 32; ++i) wv[i] *= scale[k0 + 2 * i + (lane >> 5)];
    }
#pragma unroll
    for (int i = 0; i < 32; ++i) scr[(2 * i + (lane >> 5)) * 33 + (lane & 31)] = wv[i];
    asm volatile("s_waitcnt lgkmcnt(0)" ::: "memory");
    const int c = lane & 7;
#pragma unroll
    for (int j = 0; j < 4; ++j) { const int n = (lane >> 3) + 8 * j; const LAS float* s = scr + (8 * c) * 33 + n;
        u32x4 o; o.x = cvtpk(s[0 * 33], s[1 * 33]); o.y = cvtpk(s[2 * 33], s[3 * 33]); o.z = cvtpk(s[4 * 33], s[5 * 33]); o.w = cvtpk(s[6 * 33], s[7 * 33]);
        *(u32x4*)(out + (size_t)(row_off + n0 + n) * K + k0 + 8 * c) = o; }
    asm volatile("s_waitcnt lgkmcnt(0)" ::: "memory");
}
constexpr int PREP_EARLY = 480, PREP_LATE = 448, PREP_SMALL = 64, PREP_UNITS = PREP_EARLY + PREP_LATE + PREP_SMALL;
__device__ __forceinline__ void prep_unit(const Ptrs& P, LAS unsigned char* lds, int layer, int u, int tid, int lane, int wid) {
    unsigned char* W = wbase(P.ws, P.out, layer);
    if (u < PREP_EARLY + PREP_LATE) {
        LAS float* scr = (LAS float*)(lds + wid * 8704);
        const float* w_in = P.in[2] + (size_t)layer * DM * D_IN; const float* g_pre = P.in[3] + layer * DM; const float* g_mem = P.in[5] + layer * DM;
        const float* w_mem = P.in[6] + (size_t)layer * DM * 1024; const float* w_br = P.in[18] + (size_t)layer * 4 * 512 * 1024; const float* w_gate = P.in[19] + (size_t)layer * DM * 4096; const float* w_o = P.in[20] + (size_t)layer * DM * DM;
        constexpr int I1 = 16 * (NP1 / 32), I2 = 16 * (NGATE / 32), I3 = 8 * 32, I4 = 16 * 32, I5 = 16 * 32;
        static_assert(I1 + I5 == 8 * PREP_EARLY && I2 + 4 * I3 + I4 == 8 * PREP_LATE, "prep unit counts");
        if (u < PREP_EARLY) { int r = 8 * u + wid;
            if (r < I1) prep_item(w_in, DM, D_IN, g_pre, (bf16*)(W + W_IN), 0, NP1, true, scr, r, lane);
            else prep_item(w_mem, DM, 1024, g_mem, (bf16*)(W + W_M), 0, 1024, false, scr, r - I1, lane);
        } else { int r = 8 * (u - PREP_EARLY) + wid;
            if (r < I2) prep_item(w_gate, DM, NGATE, g_pre, (bf16*)(W + W_IN), NP1, NGATE, false, scr, r, lane);
            else if (r < I2 + 4 * I3) { r -= I2; const int n = r / I3; prep_item(w_br + (size_t)n * 512 * 1024, 512, 1024, nullptr, (bf16*)(W + W_BR) + (size_t)n * 1024 * 512, 0, 1024, false, scr, r % I3, lane); }
            else prep_item(w_o, DM, DM, nullptr, (bf16*)(W + W_O), 0, 1024, false, scr, r - I2 - 4 * I3, lane);
        }
    } else {
        const int c = u - PREP_EARLY - PREP_LATE;
        const float* w1k = P.in[12] + (size_t)layer * 2048 * 64; const float* w2k = P.in[13] + layer * 4096; const float* w1v = P.in[15] + (size_t)layer * 2048 * 64; const float* w2v = P.in[16] + layer * 4096;
        const float* a_ws = P.in[9] + (size_t)layer * 4 * 128 * 128;
        bf16* W1K = (bf16*)(W + W_1K); bf16* W1V = (bf16*)(W + W_1V); bf16* W2K = (bf16*)(W + W_2K); bf16* W2V = (bf16*)(W + W_2V); bf16* WSP = (bf16*)(W + W_WS);
#pragma unroll
        for (int q = 0; q < 4; ++q) { const int i = c * 2048 + q * 512 + tid; const int e = i >> 11, kk = i & 2047, l = kk >> 6, pp = kk & 63;
            W1K[i] = (bf16)(cvtpk(w1k[(size_t)(l * 64 + dperm(pp)) * 64 + e], 0.f) & 0xffffu); W1V[i] = (bf16)(cvtpk(w1v[(size_t)kk * 64 + e], 0.f) & 0xffffu); }
        if (tid < 64) { const int i = c * 64 + tid; const int e2 = i >> 6, h = i & 63; W2K[i] = (bf16)(cvtpk(w2k[h * 64 + dperm(e2)], 0.f) & 0xffffu); W2V[i] = (bf16)(cvtpk(w2v[h * 64 + e2], 0.f) & 0xffffu); }
#pragma unroll
        for (int q = 0; q < 2; ++q) { const int i = c * 1024 + q * 512 + tid; const int t = (i >> 7) & 127, s = i & 127; WSP[i] = (bf16)(cvtpk(s <= t ? a_ws[i] : 0.f, 0.f) & 0xffffu); }
        if (wid < 2) { const int o = 2 * c + wid; const int which = o >> 6, e = o & 63; const float* pos = (which ? P.in[14] : P.in[11]) + layer * 2048; const float* w1 = which ? w1v : w1k; float s = 0.f;
#pragma unroll
            for (int ii = 0; ii < 32; ++ii) { const int i = lane + 64 * ii; s += pos[i] * w1[(size_t)i * 64 + e]; }
            s = wave_sum(s); if (lane == 0) ((float*)(P.ws + WS_BIAS1))[o] = s; }
    }
}
__device__ __forceinline__ void prologue(const Ptrs& P, LAS unsigned char* lds, int gw, int ngw, int gtid, int ngt, int lane, int wid) {
    for (int u = blockIdx.x; u < PREP_EARLY + PREP_SMALL; u += gridDim.x) prep_unit(P, lds, 0, u < PREP_EARLY ? u : u + PREP_LATE, wid * 64 + lane, lane, wid);
    float* rc = (float*)(P.ws + WS_ROPEC); float* rs = (float*)(P.ws + WS_ROPES);
    for (int idx = gtid; idx < SEQ * 32; idx += ngt) { const int pos = idx >> 5, i = idx & 31;
        double f = 1.0; for (int k = 0; k < i; ++k) f *= 0.7498942093324559;
        const double x2 = f * f; double cs = 1.0, sn = f, tc = 1.0, ts = f;
        for (int k = 1; k <= 12; ++k) { tc *= -x2 / (double)((2 * k - 1) * (2 * k)); ts *= -x2 / (double)((2 * k) * (2 * k + 1)); cs += tc; sn += ts; }
        double rcv = 1.0, rsv = 0.0, bc = cs, bs = sn;
        for (int bit = 0; bit < 11; ++bit) { if ((pos >> bit) & 1) { const double a = rcv * bc - rsv * bs, b2 = rcv * bs + rsv * bc; rcv = a; rsv = b2; } const double nc = bc * bc - bs * bs, ns = 2.0 * bc * bs; bc = nc; bs = ns; }
        rc[idx] = (float)rcv; rs[idx] = (float)rsv; }
    const float* x = P.in[0]; const float* mem = P.in[1]; bf16* XB = (bf16*)(P.ws + WS_XB); bf16* MEMB = (bf16*)(P.ws + WS_MEMB); float* rinv = (float*)(P.ws + WS_RINV); float* rinvm = (float*)(P.ws + WS_RINVM);
    constexpr int NR = 4;
    for (int r0 = gw; r0 < NT + NMEM; r0 += NR * ngw) {
        f32x4 v[NR][4];
#pragma unroll
        for (int q = 0; q < NR; ++q) { const int r = r0 + q * ngw; if (r < NT + NMEM) { const bool ism = r >= NT; const int row = ism ? r - NT : r; const float* src = (ism ? mem : x) + (size_t)row * DM;
#pragma unroll
            for (int j = 0; j < 4; ++j) v[q][j] = *(const f32x4*)(src + 4 * lane + 256 * j); } }
#pragma unroll
        for (int q = 0; q < NR; ++q) { const int r = r0 + q * ngw; if (r < NT + NMEM) { const bool ism = r >= NT; const int row = ism ? r - NT : r; bf16* dst = (ism ? MEMB : XB) + (size_t)row * DM; float ss = 0.f;
#pragma unroll
            for (int j = 0; j < 4; ++j) { const f32x4 w4 = v[q][j]; ss += (w4[0] * w4[0] + w4[1] * w4[1]) + (w4[2] * w4[2] + w4[3] * w4[3]); u32x2 w; w.x = cvtpk(w4[0], w4[1]); w.y = cvtpk(w4[2], w4[3]); *(u32x2*)(dst + 4 * lane + 256 * j) = w; }
            ss = wave_sum(ss); if (lane == 0) (ism ? rinvm : rinv)[row] = 1.f / sqrtf(ss * (1.f / DM) + EPS); } }
    }
}
__device__ __forceinline__ void finish_layer(const Ptrs& P, int layer, int gw, int ngw, int lane) {
    float* OUT = (float*)P.out; const bf16* OUTB = (const bf16*)gate_ptr(P.ws, P.out, 0); const float* part = (const float*)(P.ws + WS_PART); const float* gp = P.in[4] + layer * DM; const float* x = P.in[0];
    bf16* XB = (bf16*)(P.ws + WS_XB); float* rinv = (float*)(P.ws + WS_RINV);
    f32x4 g4[4];
#pragma unroll
    for (int j = 0; j < 4; ++j) g4[j] = *(const f32x4*)(gp + 4 * lane + 256 * j);
    constexpr int NR = 4;
    for (int row0 = gw; row0 < NT; row0 += NR * ngw) {
        f32x4 o4[NR][4], xv[NR][4]; float sp[NR];
#pragma unroll
        for (int q = 0; q < NR; ++q) { const int row = row0 + q * ngw; if (row < NT) { sp[q] = part[(size_t)row * 16 + (lane & 15)];
#pragma unroll
            for (int j = 0; j < 4; ++j) { const size_t off = (size_t)row * DM + 4 * lane + 256 * j; { const u32x2 w = *(const u32x2*)(OUTB + off); o4[q][j] = (f32x4){bflo(w.x), bfhi(w.x), bflo(w.y), bfhi(w.y)}; }
                { const u32x2 w = *(const u32x2*)(XB + off); xv[q][j] = (f32x4){bflo(w.x), bfhi(w.x), bflo(w.y), bfhi(w.y)}; } } } }
#pragma unroll
        for (int q = 0; q < NR; ++q) { const int row = row0 + q * ngw; if (row < NT) {
            float s = sp[q]; s += __shfl_xor(s, 1); s += __shfl_xor(s, 2); s += __shfl_xor(s, 4); s += __shfl_xor(s, 8);
            const float rs = 1.f / sqrtf(s * (1.f / DM) + EPS); float ss = 0.f;
#pragma unroll
            for (int j = 0; j < 4; ++j) { const size_t off = (size_t)row * DM + 4 * lane + 256 * j; const f32x4 xn = xv[q][j] + o4[q][j] * rs * g4[j];
                if (layer == 0) { ss += (xn[0] * xn[0] + xn[1] * xn[1]) + (xn[2] * xn[2] + xn[3] * xn[3]); u32x2 w; w.x = cvtpk(xn[0], xn[1]); w.y = cvtpk(xn[2], xn[3]); *(u32x2*)(XB + off) = w; }
                else *(f32x4*)(OUT + off) = xn; }
            if (layer == 0) { ss = wave_sum(ss); if (lane == 0) rinv[row] = 1.f / sqrtf(ss * (1.f / DM) + EPS); } } }
    }
}

struct Args { Ptrs p; int nph; unsigned char prog[28]; };
constexpr int NPHASE = 13;
struct GateOrder {
    pg8::StaticOrder base;
    __device__ void init(int G, int c) { base.init(NT, DM, G, c); }
    __device__ bool next(int i, pg8::Unit& u) const { if (!base.next(i >> 2, u)) return false; u.pn += 4 * (i & 3); return true; }
    __device__ __forceinline__ void a_ready(const pg8::Unit&) const {}
    __device__ __forceinline__ void done(const pg8::Unit&) const {}
};
__device__ __forceinline__ int dequeue(unsigned* ctr, LAS int* slot, int tid) {
    __syncthreads();
    if (tid == 0) *slot = (int)atomicAdd(ctr, 1u);
    __syncthreads();
    return *slot;
}
#define QUEUE_LOOP(ctr, qslot, tid0, LIMIT, ...) do { \
        for (;;) { const int idx = dequeue(ctr, qslot, tid0); if (idx >= (LIMIT)) break; \
            { __VA_ARGS__ } } } while (0)

template <int KIND> __device__ __forceinline__ void run_phase(const Ptrs& P, LAS unsigned char* lds, int ph, int qi, int tid, int lane_in, int wid) {
    const int lane = lane_in;
    int G = gridDim.x, bid = blockIdx.x; asm volatile("" : "+s"(G), "+s"(bid));
    const int gw = bid * 8 + wid, ngw = G * 8, gtid = bid * 512 + tid, ngt = G * 512;
    unsigned* ctl = (unsigned*)(P.ws + WS_CTL); LAS int* qslot = (LAS int*)(lds + LDS_MISC);
    int dry = 0;
    if (ph >= 14 && ph <= 23) { dry = ph - 13; ph = 3; }
    int p2sel = 7, p2dry = 0;
    if (ph >= 26 && ph <= 29) { p2dry = 1; p2sel = ph == 26 ? 7 : ph == 27 ? 1 : ph == 28 ? 2 : 4; ph = 2; }
    int g1dry = 0; if (ph == 30) { g1dry = 1; ph = 1; }
    int p4part = 3;
    if (ph == 24 || ph == 25) { p4part = ph - 23; ph = 4; }
    if (ph == 0) { if (KIND < 0 || KIND == 0) prologue(P, lds, gw, ngw, gtid, ngt, lane, wid); }
        else if (ph < NPHASE) {
            const int layer = (ph - 1) / 6, sub = (ph - 1) % 6; unsigned char* W = wbase(P.ws, P.out, layer);
            if (sub == 0 && (KIND < 0 || KIND == 1)) {
                if (g1dry) { pg8::Gemm g{(const bf16*)(P.ws + WS_XB), (const bf16*)(W + W_IN), NT, NP1, DM}; pg8::StaticOrder S; S.init(NT, NP1, G, bid); pg8::EpiNone E; pg8::gemm_phase<pg8::EpiNone, pg8::StaticOrder, true, true>(lds, g, S, E, tid); }
                else { pg8::Gemm g{(const bf16*)(P.ws + WS_XB), (const bf16*)(W + W_IN), NT, NP1, DM}; pg8::StaticOrder S; S.init(NT, NP1, G, bid);
                  pg8::EpiG1 E{P.ws, P.out, (const float*)(P.ws + WS_RINV), P.in[17] + layer * 8, (const float*)(P.ws + WS_ROPEC), (const float*)(P.ws + WS_ROPES), (float*)(P.ws + WS_SM)};
                  pg8::gemm_phase<pg8::EpiG1, pg8::StaticOrder, true, true>(lds, g, S, E, tid); }
                if (!g1dry) { int tid2 = tid; asm volatile("" : "+v"(tid2)); const int tid = tid2;
                  pg8::Gemm g{(const bf16*)(P.ws + WS_MEMB), (const bf16*)(W + W_M), NMEM, 1024, DM}; pg8::StaticOrder S; S.init(NMEM, 1024, G, (bid + G / 2) % G);
                  pg8::EpiRowScale E{(bf16*)(P.ws + WS_MKV), 1024, (const float*)(P.ws + WS_RINVM)};
                  pg8::gemm_phase<pg8::EpiRowScale, pg8::StaticOrder, true, true>(lds, g, S, E, tid); }
            } else if (sub == 1 && (KIND < 0 || KIND == 2)) {
                unsigned* ctr = ctl + CW_Q + 16 * qi;
                QUEUE_LOOP(ctr, qslot, tid, 576, {
                    int lane = lane_in; asm volatile("" : "+v"(lane)); const int tid = wid * 64 + lane;
                    if (idx < 128) { if (p2sel & 1) cmp_item(P, lds, layer, (idx >> 2) & 7, (idx >> 1) & 1, idx & 1, idx >> 5, lane, wid); }
                    else if (idx < 192) { const int i = idx - 128; if (p2sel & 1) cumsum_item(P, lds, i >> 3, i & 7, tid, lane, wid); }
                    else if (idx < 320) { const int i = idx - 192; if (p2sel & 2) gmlp_item(P, lds, layer, i >> 4, i & 15, tid, lane, wid, p2dry); }
                    else { const int i = idx - 320; if (p2sel & 4) mem_item(P, lds, i >> 5, (i >> 3) & 3, i & 7, tid, lane, wid, p2dry); } });
            } else if (sub == 2 && (KIND < 0 || KIND == 3)) {
                unsigned* ctr = ctl + CW_Q + 16 * qi;
                QUEUE_LOOP(ctr, qslot, tid, ((layer == 0 && dry == 0) ? 1024 + PREP_LATE + PREP_UNITS : 1024), {
                    int lane = lane_in; asm volatile("" : "+v"(lane)); const int tid = wid * 64 + lane;
                    if (idx >= 1024) { const int f = idx - 1024; if (f < PREP_LATE) prep_unit(P, lds, 0, PREP_EARLY + f, tid, lane, wid); else prep_unit(P, lds, 1, f - PREP_LATE, tid, lane, wid); continue; }
                    int isn, i, q;
                    if (idx < 256) { isn = 1; i = idx; q = 31 - (i >> 4); }
                    else if (idx < 512) { isn = 0; i = idx - 256; q = 7 - (i >> 6); }
                    else if (idx < 640) { isn = 1; i = idx - 512; q = 15 - (i >> 4); }
                    else if (idx < 768) { isn = 0; i = idx - 640; q = 3 - (i >> 6); }
                    else if (idx < 896) { isn = 1; i = idx - 768; q = 7 - (i >> 4); }
                    else { isn = 0; i = idx - 896; q = 1 - (i >> 6); }
                    if (isn) { if (dry == 0 || dry == 2 || dry >= 8) nsa_item(P, lds, (i & 15) >> 1, i & 1, q, tid, lane, wid, dry); }
                    else { if (dry < 2) fa_item(P, lds, (i & 63) >> 3, i & 7, q, tid, lane, wid, dry); } });
            } else if (sub == 3 && (KIND < 0 || KIND == 4)) {
                unsigned char* g0 = gate_ptr(P.ws, P.out, 0); unsigned char* g1 = gate_ptr(P.ws, P.out, 1); unsigned char* g2 = gate_ptr(P.ws, P.out, 2); unsigned char* g3 = gate_ptr(P.ws, P.out, 3);
                if (p4part & 1) { pg8::Gemm g{(const bf16*)(P.ws + WS_XB), (const bf16*)(W + W_IN) + (size_t)NP1 * DM, NT, NGATE, DM}; GateOrder S; S.init(G, bid);
                  pg8::EpiGate E{g0, g1, g2, g3, (const float*)(P.ws + WS_RINV)};
                  pg8::gemm_phase<pg8::EpiGate, GateOrder, true, true>(lds, g, S, E, tid); }
                if (p4part & 2) { int tid2 = tid; asm volatile("" : "+v"(tid2)); const int tid = tid2;
                  pg8::Gemm g{(const bf16*)slot_ptr(P.ws, P.out, 0), (const bf16*)(W + W_BR), 4 * NT, 4096, 512}; pg8::MergeOrder S; S.init(G, bid);
                  pg8::EpiMerge E{g0, g1, g2, g3, (bf16*)(P.ws + WS_MERGED)};
                  pg8::gemm_phase<pg8::EpiMerge, pg8::MergeOrder, true, true>(lds, g, S, E, tid); }
            } else if (sub == 4 && (KIND < 0 || KIND == 5)) {
                pg8::Gemm g{(const bf16*)(P.ws + WS_MERGED), (const bf16*)(W + W_O), NT, DM, DM}; pg8::StaticOrder S; S.init(NT, DM, G, bid);
                pg8::EpiOut E{(bf16*)gate_ptr(P.ws, P.out, 0), (float*)(P.ws + WS_PART)};
                pg8::gemm_phase<pg8::EpiOut, pg8::StaticOrder, true, true>(lds, g, S, E, tid);
            } else if (sub == 5 && (KIND < 0 || KIND == 6)) {
                finish_layer(P, layer, gw, ngw, lane);
            }
        }
}
#define XB_TMO      128
#define XB_XCNT(j)  (256  + 64 * (j))
#define XB_XSUB(j)  (1280 + 64 * (j))
#define XB_XGEN(j)  (2304 + 64 * (j))
#define XB_TOP      3328
#define XB_TOPGEN   3392
#define XCD_BAR_WORDS 3456
#define XB_SPIN_CAP (1u << 18)

__device__ __forceinline__ unsigned xb_ld(unsigned* p)              { return __hip_atomic_load(p, __ATOMIC_RELAXED, __HIP_MEMORY_SCOPE_AGENT); }
__device__ __forceinline__ unsigned xb_add(unsigned* p, unsigned v) { return __hip_atomic_fetch_add(p, v, __ATOMIC_RELAXED, __HIP_MEMORY_SCOPE_AGENT); }
__device__ __forceinline__ unsigned xb_xcc_id() { return (unsigned)__builtin_amdgcn_s_getreg((3 << 11) | 20) & 0xFu; }
#define XB_SPIN(cond, bar) do { unsigned _sp = 0; while (cond) { __builtin_amdgcn_s_sleep(1); \
    if ((++_sp & 255u) == 0u) { if (xb_ld(&(bar)[XB_TMO])) break; if (_sp > XB_SPIN_CAP) { atomicAdd(&(bar)[XB_TMO], 1u); break; } } } } while (0)

struct XcdBarrier {
    unsigned* bar; unsigned x;
    volatile LAS unsigned* st;
};

__device__ __forceinline__ XcdBarrier xcd_barrier_post(unsigned* bar, volatile LAS unsigned* st) {
    XcdBarrier b; b.bar = bar; b.x = xb_xcc_id(); b.st = st;
    if (threadIdx.x == 0) (void)xb_add(&bar[XB_XCNT(b.x)], 1u);
    return b;
}
__device__ __forceinline__ void xcd_barrier_complete(unsigned* bar, unsigned x, unsigned& nloc, unsigned& nx) {
    const unsigned G = gridDim.x * gridDim.y * gridDim.z;
    unsigned sum, cnt, mine, sp = 0u;
    for (;;) {
        sum = 0u; cnt = 0u; mine = 0u;
#pragma unroll
        for (unsigned j = 0; j < 16; ++j) { const unsigned c = xb_ld(&bar[XB_XCNT(j)]); sum += c; cnt += (c > 0u) ? 1u : 0u; mine = (j == x) ? c : mine; }
        if (sum == G) break;
        __builtin_amdgcn_s_sleep(1);
        if ((++sp & 255u) == 0u) { if (xb_ld(&bar[XB_TMO])) break; if (sp > XB_SPIN_CAP) { atomicAdd(&bar[XB_TMO], 1u); break; } }
    }
    nloc = mine > 0u ? mine : 1u; nx = cnt > 0u ? cnt : 1u;
}

__device__ __forceinline__ void xcd_barrier(const XcdBarrier& b) {
    asm volatile("s_waitcnt vmcnt(0)" ::: "memory");
    __syncthreads();
    if (threadIdx.x == 0) {
        unsigned* bar = b.bar;
        __builtin_amdgcn_s_waitcnt(0);
        unsigned nloc = b.st[0], nx = b.st[1];
        if (nloc == 0u) { xcd_barrier_complete(bar, b.x, nloc, nx); b.st[0] = nloc; b.st[1] = nx; }
        const unsigned old = xb_add(&bar[XB_XSUB(b.x)], 1u);
        const unsigned gen = old / nloc;
        if (old + 1u == (gen + 1u) * nloc) {
            __builtin_amdgcn_fence(__ATOMIC_RELEASE, "agent");
            asm volatile("s_waitcnt vmcnt(0)" ::: "memory");
            const unsigned og = xb_add(&bar[XB_TOP], 1u);
            const unsigned tg = og / nx;
            if (og + 1u == (tg + 1u) * nx) xb_add(&bar[XB_TOPGEN], 1u);
            else XB_SPIN(xb_ld(&bar[XB_TOPGEN]) == tg, bar);
            __builtin_amdgcn_fence(__ATOMIC_ACQUIRE, "agent");
            xb_add(&bar[XB_XGEN(b.x)], 1u);
            asm volatile("s_waitcnt vmcnt(0)" ::: "memory");
        } else {
            XB_SPIN(xb_ld(&bar[XB_XGEN(b.x)]) == gen, bar);
            __builtin_amdgcn_fence(__ATOMIC_ACQUIRE, "agent");
            asm volatile("s_waitcnt vmcnt(0)" ::: "memory");
        }
    }
    __syncthreads();
}

constexpr int CW_BAR = 4096;
typedef const __attribute__((address_space(4))) Args* KArgP;
__global__ void __launch_bounds__(512, 2) hybrid_fwd(Args a_unused) {
    extern __shared__ __attribute__((aligned(16))) unsigned char lds_raw[];
    KArgP kp = (KArgP)__builtin_amdgcn_kernarg_segment_ptr();
    const int nph = kp->nph;
    const int wid0 = __builtin_amdgcn_readfirstlane((int)threadIdx.x >> 6);
    {
        volatile LAS unsigned* st = (volatile LAS unsigned*)((LAS unsigned char*)lds_raw + LDS_MISC + 16);
        if (threadIdx.x < 2) st[threadIdx.x] = 0u;
        __syncthreads();
        (void)xcd_barrier_post((unsigned*)(kp->p.ws + WS_CTL) + CW_BAR, st);
    }
    for (int pi = 0; pi < nph; ++pi) {
        int wid = wid0; asm volatile("" : "+s"(wid));
        int lane; asm volatile("v_mbcnt_lo_u32_b32 %0, -1, 0\n\tv_mbcnt_hi_u32_b32 %0, -1, %0" : "=v"(lane));
        const int tid = wid * 64 + lane;
        KArgP kq = kp; asm volatile("" : "+s"(kq));
        LAS unsigned char* lds = (LAS unsigned char*)lds_raw;
        Ptrs P;
#pragma unroll
        for (int i = 0; i < 21; ++i) P.in[i] = kq->p.in[i];
        P.out = kq->p.out; P.ws = kq->p.ws;
        const int ph = kq->prog[pi];
        run_phase<-1>(P, lds, ph, pi, tid, lane, wid);
        if (pi + 1 < nph) {
            if (nph > 64) cg::this_grid().sync();
            else { XcdBarrier b; b.bar = (unsigned*)(P.ws + WS_CTL) + CW_BAR; b.x = xb_xcc_id(); b.st = (volatile LAS unsigned*)(lds + LDS_MISC + 16); xcd_barrier(b); }
        }
    }
}
#ifdef DIAG_KERNELS
template <int KIND> __global__ void __launch_bounds__(512, 2) phase_k(Args a) {
    extern __shared__ __attribute__((aligned(16))) unsigned char lds_raw[];
    LAS unsigned char* lds = (LAS unsigned char*)lds_raw;
    const int tid = threadIdx.x, lane = tid & 63, wid = __builtin_amdgcn_readfirstlane(tid >> 6);
    run_phase<KIND>(a.p, lds, a.prog[0], 0, tid, lane, wid);
}
template __global__ void phase_k<0>(Args);
template __global__ void phase_k<1>(Args);
template __global__ void phase_k<2>(Args);
template __global__ void phase_k<3>(Args);
template __global__ void phase_k<4>(Args);
template __global__ void phase_k<5>(Args);
template __global__ void phase_k<6>(Args);

#endif
extern "C" void kernel_launch(void* const* d_in, const int* in_sizes, int n_in, void* d_out, int out_size, void* d_ws, size_t ws_size, hipStream_t stream) {
    static int grid = 0;
    if (grid == 0) {
        if (n_in != 21 || out_size != NT * DM || ws_size < WS_NEED) { fprintf(stderr, "kernel_launch: unexpected shapes (n_in %d out %d ws %zu)\n", n_in, out_size, ws_size); grid = -1; return; }
        int dev = 0, cus = 0, per_cu = 0;
        hipGetDevice(&dev); hipDeviceGetAttribute(&cus, hipDeviceAttributeMultiprocessorCount, dev);
        if (hipFuncSetAttribute((const void*)hybrid_fwd, hipFuncAttributeMaxDynamicSharedMemorySize, LDS_BYTES) != hipSuccess) { fprintf(stderr, "kernel_launch: hipFuncSetAttribute failed\n"); grid = -1; return; }
        hipOccupancyMaxActiveBlocksPerMultiprocessor(&per_cu, (const void*)hybrid_fwd, 512, LDS_BYTES);
        (void)hipGetLastError();
        if (per_cu < 1) { fprintf(stderr, "kernel_launch: occupancy query reports %d blocks per CU\n", per_cu); per_cu = 1; }
        grid = cus;
        if (grid % 8 != 0) grid -= grid % 8;
    }
    if (grid < 0) return;
    (void)hipMemsetAsync((char*)d_ws + WS_CTL, 0, 32768, stream);
    Args a{};
    for (int i = 0; i < 21; ++i) a.p.in[i] = (const float*)d_in[i];
    a.p.out = (unsigned char*)d_out; a.p.ws = (unsigned char*)d_ws;
    int n = 0;
#ifdef PROG_CUSTOM
    { const unsigned char pc[] = PROG_CUSTOM; for (unsigned i = 0; i < sizeof(pc); ++i) a.prog[n++] = pc[i]; }
#else
    for (int ph = 0; ph < NPHASE; ++ph) a.prog[n++] = (unsigned char)ph;
#endif
#if ONE_LAUNCH
    a.nph = n;
    void* args[] = {&a};
    hipError_t e = hipLaunchCooperativeKernel((const void*)hybrid_fwd, dim3(grid), dim3(512), args, LDS_BYTES, stream);
    if (e != hipSuccess) fprintf(stderr, "kernel_launch: cooperative launch failed: %s (grid %d)\n", hipGetErrorString(e), grid);
#else
    { Args b = a; b.nph = 1; for (int i = 0; i < n; ++i) { b.prog[0] = a.prog[i]; hipLaunchKernelGGL(hybrid_fwd, dim3(grid), dim3(512), LDS_BYTES, stream, b); } }
#endif
}
```

```cpp
#include <hip/hip_runtime.h>
#include <hip/hip_cooperative_groups.h>
#include <cstdio>
#include <cstdint>
#include <cmath>
namespace cg = cooperative_groups;
#ifndef ONE_LAUNCH
#define ONE_LAUNCH 1
#endif
namespace pg8 {
#define PG8_LAS __attribute__((address_space(3)))
typedef unsigned short bf16_t;
typedef short bf16x8 __attribute__((ext_vector_type(8)));
typedef float f32x4 __attribute__((ext_vector_type(4)));
typedef unsigned u32x4 __attribute__((ext_vector_type(4)));
constexpr int BM = 256, BK = 64, HALF = 128, HTB = HALF * BK * 2  , STAGE_BYTES = 8 * HTB, NXCD = 8, WGM = 8;

__host__ __device__ __forceinline__ int lds_byte(int r, int c) { const int st = (r >> 4) * 2 + (c >> 5), rr = r & 15, cc = c & 31, ob = rr * 64 + cc * 2; return st * 1024 + (ob ^ (((ob >> 9) & 1) << 5)); }
__host__ __device__ __forceinline__ void stage_rc(int b, int& R, int& C) { const int st = b / 1024, sb = b % 1024, swz = sb ^ (((sb >> 9) & 1) << 5); R = (st >> 1) * 16 + swz / 64; C = (st & 1) * 32 + (swz % 64) / 2; }
__host__ __device__ __forceinline__ int perm32(int rho) { const int n = rho >> 4, i = rho & 15; return 8 * (i >> 2) + 4 * n + (i & 3); }

struct Unit { int pm, pn; };
struct Gemm { const bf16_t* A; const bf16_t* Bt; int M, N, K; };

struct StaticOrder {
    int nM, nN, nwg, G, c;
    __host__ __device__ void init(int M, int N, int G_, int c_) { nM = M / BM; nN = N / BM; nwg = nM * nN; G = G_; c = c_; }
    __host__ __device__ bool next(int i, Unit& u) const {
        const long L = (long)i * G + c; if (L >= nwg) return false;
        int wgid = (int)L; { const int q = nwg / NXCD, r = nwg % NXCD, xcd = wgid % NXCD, off = wgid / NXCD; wgid = (xcd < r ? xcd * (q + 1) : r * (q + 1) + (xcd - r) * q) + off; }
        const int nig = WGM * nN, gid = wgid / nig, fm = gid * WGM, gsz = (nM - fm) < WGM ? (nM - fm) : WGM;
        u.pm = fm + ((wgid % nig) % gsz); u.pn = (wgid % nig) / gsz; return true;
    }
    __device__ __forceinline__ void a_ready(const Unit&) const {}
    __device__ __forceinline__ void done(const Unit&) const {}
};

template <class Epi, class Sched, bool ALIGN_EPI = false, bool SP2 = false>
__device__ __forceinline__ void gemm_phase(PG8_LAS unsigned char* lds, const Gemm g, const Sched& S, const Epi& E, const int tid) {
    const int wid = __builtin_amdgcn_readfirstlane(tid >> 6), lane = tid & 63, wr = wid >> 2, wc = wid & 3, fr = lane & 15, fq = lane >> 4;
    const int K = g.K, nt = K / BK;
    unsigned voffA[2], voffB[2];
#pragma unroll
    for (int i = 0; i < 2; ++i) { int R, C; stage_rc(tid * 16 + i * 8192, R, C); const int Rb = Epi::PERM ? ((R & ~31) + perm32(R & 31)) : R;
        voffA[i] = (unsigned)(R * K + C) * 2u; voffB[i] = (unsigned)(Rb * K + C) * 2u; }
    const size_t kstep = (size_t)(BK * 2);
    const size_t hstep = (size_t)HALF * K * 2;
    const size_t tstep = 2 * hstep;
    const unsigned ldsw = (unsigned)wid * 1024u;
    const int aoff = lds_byte(wr * 64 + fr, fq * 8), boff = lds_byte(wc * 32 + fr, fq * 8);
#define PG8_SA(b, h) (((b) * 2 + (h)) * HTB)
#define PG8_SB(b, h) ((4 + (b) * 2 + (h)) * HTB)
#define PG8_STAGE(bufoff, gbase, voff) do { _Pragma("unroll") for (int _i = 0; _i < 2; ++_i) \
        __builtin_amdgcn_global_load_lds((const unsigned*)((const char*)(gbase) + (voff)[_i]), (PG8_LAS unsigned*)(lds + (bufoff) + ldsw + _i * 8192), 16, 0, 0); } while (0)
#define PG8_LDA(dst, b, h) do { _Pragma("unroll") for (int m = 0; m < 4; ++m) _Pragma("unroll") for (int k = 0; k < 2; ++k) dst[m][k] = *(const PG8_LAS bf16x8*)(lds + PG8_SA(b, h) + aoff + m * 2048 + k * 1024); } while (0)
#define PG8_LDB(dst, b, h) do { _Pragma("unroll") for (int n = 0; n < 2; ++n) _Pragma("unroll") for (int k = 0; k < 2; ++k) dst[n][k] = *(const PG8_LAS bf16x8*)(lds + PG8_SB(b, h) + boff + n * 2048 + k * 1024); } while (0)
#define PG8_MMA(ai, bj, At, Bt) do { __builtin_amdgcn_s_setprio(1); _Pragma("unroll") for (int m = 0; m < 4; ++m) _Pragma("unroll") for (int n = 0; n < 2; ++n) _Pragma("unroll") for (int k = 0; k < 2; ++k) \
        acc[ai][bj][m][n] = __builtin_amdgcn_mfma_f32_16x16x32_bf16(Bt[n][k], At[m][k], acc[ai][bj][m][n], 0, 0, 0); __builtin_amdgcn_s_setprio(0); } while (0)
#define PG8_WAIT_V(n) asm volatile("s_waitcnt vmcnt(" #n ")" ::: "memory")
#define PG8_WAIT_L(n) asm volatile("s_waitcnt lgkmcnt(" #n ")" ::: "memory")
#define PG8_BAR __builtin_amdgcn_s_barrier()
#define PG8_SCHED __builtin_amdgcn_sched_barrier(0)
    Unit cur, nxt; int ui = 0;
    if (!S.next(0, cur)) return;
    f32x4 acc[2][2][4][2];
#pragma unroll
    for (int a = 0; a < 2; ++a)
#pragma unroll
        for (int b = 0; b < 2; ++b)
#pragma unroll
            for (int m = 0; m < 4; ++m)
#pragma unroll
                for (int n = 0; n < 2; ++n) acc[a][b][m][n] = (f32x4){0.f, 0.f, 0.f, 0.f};
    bf16x8 At[4][2], B0[2][2], B1[2][2];
    const char* cA = (const char*)g.A + (size_t)cur.pm * tstep; const char* cB = (const char*)g.Bt + (size_t)cur.pn * tstep;
    S.a_ready(cur);
    if constexpr (SP2) {
        PG8_STAGE(PG8_SB(0, 0), cB, voffB); PG8_STAGE(PG8_SB(0, 1), cB + hstep, voffB); PG8_STAGE(PG8_SA(0, 0), cA, voffA); PG8_STAGE(PG8_SA(0, 1), cA + hstep, voffA);
        if (wr == 1) PG8_BAR;
        PG8_WAIT_V(2); PG8_BAR;
        PG8_STAGE(PG8_SB(1, 0), cB + kstep, voffB); PG8_STAGE(PG8_SA(1, 0), cA + kstep, voffA); PG8_STAGE(PG8_SB(1, 1), cB + hstep + kstep, voffB);
        PG8_WAIT_V(6); PG8_BAR;
    } else {
        PG8_STAGE(PG8_SB(0, 0), cB, voffB); PG8_STAGE(PG8_SA(0, 0), cA, voffA); PG8_STAGE(PG8_SB(0, 1), cB + hstep, voffB); PG8_STAGE(PG8_SA(0, 1), cA + hstep, voffA);
        if (wr == 1) PG8_BAR;
        PG8_WAIT_V(4); PG8_BAR;
        PG8_STAGE(PG8_SB(1, 0), cB + kstep, voffB); PG8_STAGE(PG8_SA(1, 0), cA + kstep, voffA); PG8_STAGE(PG8_SB(1, 1), cB + hstep + kstep, voffB);
        PG8_WAIT_V(6); PG8_BAR;
    }
    for (;;) {
        const bool has_next = S.next(ui + 1, nxt);
        const char* nA = has_next ? (const char*)g.A + (size_t)nxt.pm * tstep : cA; const char* nB = has_next ? (const char*)g.Bt + (size_t)nxt.pn * tstep : cB;
        for (int t = 0; t < nt; t += 2) {
            const bool last = (t == nt - 2);
            const char* a1 = cA + (size_t)(t + 1) * kstep;
            const char* a2 = last ? nA : cA + (size_t)(t + 2) * kstep; const char* b2 = last ? nB : cB + (size_t)(t + 2) * kstep;
            const char* a3 = a2 + kstep; const char* b3 = b2 + kstep;
            if (last && has_next) S.a_ready(nxt);
            if constexpr (SP2) {
            PG8_LDB(B0, 0, 0); PG8_LDB(B1, 0, 1); PG8_SCHED; PG8_LDA(At, 0, 0); PG8_STAGE(PG8_SA(1, 1), a1 + hstep, voffA);
            PG8_WAIT_V(8); PG8_WAIT_L(0); PG8_BAR; PG8_MMA(0, 0, At, B0); PG8_MMA(0, 1, At, B1); PG8_BAR; PG8_SCHED;
            PG8_LDA(At, 0, 1); PG8_STAGE(PG8_SB(0, 0), b2, voffB); PG8_STAGE(PG8_SB(0, 1), b2 + hstep, voffB); PG8_STAGE(PG8_SA(0, 0), a2, voffA);
            PG8_WAIT_V(8); PG8_WAIT_L(0); PG8_BAR; PG8_MMA(1, 0, At, B0); PG8_MMA(1, 1, At, B1); PG8_BAR; PG8_SCHED;
            PG8_LDB(B0, 1, 0); PG8_LDB(B1, 1, 1); PG8_SCHED; PG8_LDA(At, 1, 0); PG8_STAGE(PG8_SA(0, 1), a2 + hstep, voffA);
            PG8_WAIT_V(8); PG8_WAIT_L(0); PG8_BAR; PG8_MMA(0, 0, At, B0); PG8_MMA(0, 1, At, B1); PG8_BAR; PG8_SCHED;
            PG8_LDA(At, 1, 1); PG8_STAGE(PG8_SB(1, 0), b3, voffB); PG8_STAGE(PG8_SB(1, 1), b3 + hstep, voffB); PG8_STAGE(PG8_SA(1, 0), a3, voffA);
            PG8_WAIT_V(8); PG8_WAIT_L(0); PG8_BAR; PG8_MMA(1, 0, At, B0); PG8_MMA(1, 1, At, B1); PG8_BAR; PG8_SCHED;
            } else {
            PG8_LDB(B0, 0, 0); PG8_SCHED; PG8_LDA(At, 0, 0); PG8_STAGE(PG8_SA(1, 1), a1 + hstep, voffA);
            PG8_WAIT_L(8); PG8_BAR; PG8_WAIT_L(0); PG8_MMA(0, 0, At, B0); PG8_BAR; PG8_SCHED;
            PG8_LDB(B1, 0, 1); PG8_STAGE(PG8_SB(0, 0), b2, voffB);
            PG8_BAR; PG8_WAIT_L(0); PG8_MMA(0, 1, At, B1); PG8_BAR;
            PG8_LDA(At, 0, 1); PG8_STAGE(PG8_SA(0, 0), a2, voffA);
            PG8_BAR; PG8_WAIT_L(0); PG8_MMA(1, 0, At, B0); PG8_BAR; PG8_SCHED;
            PG8_STAGE(PG8_SB(0, 1), b2 + hstep, voffB);
            PG8_WAIT_V(6); PG8_BAR; PG8_MMA(1, 1, At, B1); PG8_BAR;
            PG8_LDB(B0, 1, 0); PG8_SCHED; PG8_LDA(At, 1, 0); PG8_STAGE(PG8_SA(0, 1), a2 + hstep, voffA);
            PG8_WAIT_L(8); PG8_BAR; PG8_WAIT_L(0); PG8_MMA(0, 0, At, B0); PG8_BAR; PG8_SCHED;
            PG8_LDB(B1, 1, 1); PG8_STAGE(PG8_SB(1, 0), b3, voffB);
            PG8_BAR; PG8_WAIT_L(0); PG8_MMA(0, 1, At, B1); PG8_BAR;
            PG8_LDA(At, 1, 1); PG8_STAGE(PG8_SA(1, 0), a3, voffA);
            PG8_BAR; PG8_WAIT_L(0); PG8_MMA(1, 0, At, B0); PG8_BAR; PG8_SCHED;
            PG8_STAGE(PG8_SB(1, 1), b3 + hstep, voffB);
            PG8_WAIT_V(6); PG8_BAR; PG8_MMA(1, 1, At, B1); PG8_BAR;
            }
        }
        if constexpr (ALIGN_EPI) { if (wr == 0) PG8_BAR; }
        if constexpr (!Epi::AFTER_DRAIN) { E(acc, cur, wr, wc, fr, fq); S.done(cur); }
        if (!has_next) break;
#pragma unroll
        for (int a = 0; a < 2; ++a)
#pragma unroll
            for (int b = 0; b < 2; ++b)
#pragma unroll
                for (int m = 0; m < 4; ++m)
#pragma unroll
                    for (int n = 0; n < 2; ++n) acc[a][b][m][n] = (f32x4){0.f, 0.f, 0.f, 0.f};
        cur = nxt; cA = nA; cB = nB; ++ui;
        if constexpr (ALIGN_EPI) { if (wr == 1) PG8_BAR; }
    }
    PG8_WAIT_V(0);
    if constexpr (!ALIGN_EPI) { if (wr == 0) PG8_BAR; }
    PG8_BAR;
    if constexpr (Epi::AFTER_DRAIN) { E.fused(acc, cur, wr, wc, fr, fq, lds, wid, lane); S.done(cur); }
#undef PG8_SA
#undef PG8_SB
#undef PG8_STAGE
#undef PG8_LDA
#undef PG8_LDB
#undef PG8_MMA
#undef PG8_WAIT_V
#undef PG8_WAIT_L
#undef PG8_BAR
#undef PG8_SCHED
}
}

#define LAS __attribute__((address_space(3)))
typedef unsigned short bf16;
typedef short bf16x8 __attribute__((ext_vector_type(8)));
typedef short s16x4 __attribute__((ext_vector_type(4)));
typedef float f32x4 __attribute__((ext_vector_type(4)));
typedef float f32x16 __attribute__((ext_vector_type(16)));
typedef unsigned u32x4 __attribute__((ext_vector_type(4)));
typedef unsigned u32x2 __attribute__((ext_vector_type(2)));

constexpr int NB = 8, SEQ = 2048, DM = 1024, NT = NB * SEQ, MEMLEN = 256, NMEM = NB * MEMLEN;
constexpr int D_IN = 6432, NP1 = 6656, NGATE = 4096, NW1 = NP1 + NGATE;
constexpr float EPS = 1e-6f, LOG2E = 1.4426950408889634f;
constexpr float QSC = 0.125f * LOG2E;
constexpr float MSC = 0.08838834764831845f * LOG2E;
constexpr size_t MiB = 1u << 20;
constexpr size_t WS_CTL = 0;
constexpr size_t WS_ROPEC = 1 * MiB, WS_ROPES = WS_ROPEC + 256 * 1024;
constexpr size_t WS_RINV = WS_ROPES + 256 * 1024;
constexpr size_t WS_RINVM = WS_RINV + 64 * 1024;
constexpr size_t WS_BIAS1 = WS_RINVM + 8 * 1024;
constexpr size_t WS_CS = 2 * MiB;
constexpr size_t WS_KCMP = WS_CS + 512 * 1024, WS_VCMP = WS_KCMP + 256 * 1024;
constexpr size_t WS_PART = 3 * MiB;
constexpr size_t WS_SM = 4 * MiB;
constexpr size_t WS_W = 6 * MiB;
constexpr size_t W_IN = 0, W_BR = 21 * MiB, W_O = 25 * MiB, W_M = 27 * MiB, W_1K = 29 * MiB, W_1V = W_1K + 256 * 1024, W_2K = W_1V + 256 * 1024, W_2V = W_2K + 8192, W_WS = W_2K + 256 * 1024;
constexpr size_t WS_XB = 38 * MiB, WS_MEMB = 70 * MiB, WS_MKV = 74 * MiB, WS_SLOT = 78 * MiB, SLOTB = 16 * MiB;
constexpr size_t WS_KVS = 222 * MiB;
constexpr size_t WS_MERGED = 206 * MiB;
constexpr size_t WS_KX = 246 * MiB, WS_QX = 250 * MiB;
constexpr size_t WS_NEED = 256 * MiB;
constexpr int CW_Q = 64;
constexpr int LDS_BYTES = 147456;
constexpr int LDS_MISC = 143360;

__device__ __forceinline__ unsigned char* wbase(unsigned char* ws, unsigned char* dout, int layer) { return layer ? dout + 32 * MiB : ws + WS_W; }
__device__ __forceinline__ unsigned char* slot_ptr(unsigned char* ws, unsigned char* dout, int i) { return i < 9 ? ws + WS_SLOT + (size_t)i * SLOTB : dout + (size_t)(i - 9) * SLOTB; }
enum { SL_U = 0, SL_BQ = 1, SL_CQ = 2, SL_MQ = 3, SL_V = 4, SL_AZ = 5, SL_BZ = 6, SL_CK = 7, SL_CV = 8, SL_CZ = 9, SL_MZ = 10 };
__device__ __forceinline__ unsigned char* gate_ptr(unsigned char* ws, unsigned char* dout, int n) { return slot_ptr(ws, dout, 4 + n); }

__device__ __forceinline__ unsigned cvtpk(float lo, float hi) { typedef float f2 __attribute__((ext_vector_type(2))); typedef __bf16 b2 __attribute__((ext_vector_type(2))); f2 v = {lo, hi}; b2 b = __builtin_convertvector(v, b2); return __builtin_bit_cast(unsigned, b); }
__device__ __forceinline__ float bflo(unsigned w) { return __uint_as_float(w << 16); }
__device__ __forceinline__ float bfhi(unsigned w) { return __uint_as_float(w & 0xffff0000u); }
__device__ __forceinline__ float ex2(float x) { return __builtin_amdgcn_exp2f(x); }
__device__ __forceinline__ float rcp(float x) { return __builtin_amdgcn_rcpf(x); }
__device__ __forceinline__ float sigm(float x) { return rcp(1.f + ex2(-LOG2E * x)); }
__device__ __forceinline__ float silu_f(float x) { return x * sigm(x); }
__device__ __forceinline__ float gelu_f(float x) { const float u = 0.7978845608028654f * (x + 0.044715f * x * x * x); return x * sigm(2.f * u); }
__device__ __forceinline__ float wave_sum(float v) {
#pragma unroll
    for (int o = 1; o < 64; o <<= 1) v += __shfl_xor(v, o);
    return v;
}
__device__ __forceinline__ int crow(int r, int hi) { return (r & 3) + 8 * (r >> 2) + 4 * hi; }
__device__ __forceinline__ int dperm(int pp) { return (pp >> 1) + 32 * (pp & 1); }

__device__ __forceinline__ int proj_src(int p) {
    if (p < 1536) return p;
    if (p < 2432) {
        int base;
        if (p < 2048) base = 1536 + ((p - 1536) & ~63);
        else if (p < 2176) base = 2048 + ((p - 2048) & ~63);
        else if (p < 2304) base = 2304 + ((p - 2176) & ~63);
        else base = 2560 + ((p - 2304) & ~63);
        return base + dperm(p & 63);
    }
    if (p < 2560) return 2176 + (p - 2432);
    if (p < 2688) return 2432 + (p - 2560);
    if (p < 2816) return 2688 + (p - 2688);
    if (p < 3328) return 2840 + (p - 2816);
    if (p < 3840) return 3352 + (p - 3328);
    if (p < 4352) return 3864 + (p - 3840);
    if (p < 4864) return 4376 + (p - 4352);
    if (p < 5376) return 4896 + (p - 4864);
    if (p < 5888) return 5408 + (p - 5376);
    if (p < 6400) return 5920 + (p - 5888);
    if (p < 6424) return 2816 + (p - 6400);
    if (p < 6432) return 4888 + (p - 6424);
    return -1;
}

namespace pg8 {
struct EpiG1 {
    static constexpr bool PERM = true, AFTER_DRAIN = false;
    unsigned char* ws; unsigned char* dout; const float* rinv; const float* fbias; const float* ropec; const float* ropes; float* sm;
    __device__ __forceinline__ void operator()(const f32x4 (&acc)[2][2][4][2], const Unit& u, int wr, int wc, int fr, int fq) const {
        const int row0 = u.pm * 256 + wr * 64 + fr; const int bt = u.pm >> 3;
        float rv[2][4];
#pragma unroll
        for (int ai = 0; ai < 2; ++ai)
#pragma unroll
            for (int m = 0; m < 4; ++m) rv[ai][m] = rinv[row0 + ai * 128 + m * 16];
#pragma unroll
        for (int bj = 0; bj < 2; ++bj) {
            const int P = u.pn * 256 + bj * 128 + wc * 32;
            if (P >= 6432) continue;
            if (P >= 6400) {
#pragma unroll
                for (int ai = 0; ai < 2; ++ai)
#pragma unroll
                    for (int m = 0; m < 4; ++m) {
                        const int row = row0 + ai * 128 + m * 16; const float r = rv[ai][m];
                        float v[8];
#pragma unroll
                        for (int j = 0; j < 4; ++j) { v[j] = acc[ai][bj][m][0][j] * r; v[4 + j] = acc[ai][bj][m][1][j] * r; }
                        if (fq < 3) {
#pragma unroll
                            for (int j = 0; j < 8; ++j) v[j] = sigm(v[j]);
                        } else {
#pragma unroll
                            for (int j = 0; j < 8; ++j) { const float x = v[j] + fbias[j]; const float ax = fabsf(x);
                                const float sp = __logf(1.f + __expf(-ax));
                                v[j] = (fminf(x, 0.f) - sp) * LOG2E; }
                        }
                        float* d = sm + (size_t)row * 32 + 8 * fq;
                        *(f32x4*)d = (f32x4){v[0], v[1], v[2], v[3]}; *(f32x4*)(d + 4) = (f32x4){v[4], v[5], v[6], v[7]};
                    }
                continue;
            }
            const int seg = P >> 7; int kind = 0, ld = 512, col, rowadd = 0, sl = 0; float sc = 1.f; bf16* dst;
            if (seg < 4) { kind = 0; sl = SL_U; col = P; }
            else if (seg < 8) { kind = 1; sl = SL_V; col = P - 512; }
            else if (seg < 12) { kind = 0; sl = SL_AZ; col = P - 1024; }
            else if (seg < 16) { kind = 3; sl = SL_BQ; col = P - 1536; sc = QSC; }
            else if (seg < 22) { kind = seg < 19 ? 3 : 0; sl = -1; ld = 64; col = P & 63; rowadd = (bt + ((P >> 6) & 1)) * 2048; }
            else if (seg < 26) { kind = 0; sl = SL_BZ; col = P - 2816; }
            else if (seg < 30) { kind = 0; sl = SL_CQ; col = P - 3328; sc = QSC; }
            else if (seg < 34) { kind = 0; sl = SL_CK; col = P - 3840; }
            else if (seg < 38) { kind = 0; sl = SL_CV; col = P - 4352; }
            else if (seg < 42) { kind = 0; sl = SL_CZ; col = P - 4864; }
            else if (seg < 46) { kind = 0; sl = SL_MQ; col = P - 5376; sc = MSC; }
            else { kind = 0; sl = SL_MZ; col = P - 5888; }
            if (sl >= 0) dst = (bf16*)slot_ptr(ws, dout, sl); else dst = (bf16*)(ws + WS_KVS + (size_t)(seg - 16) * 4 * MiB);
            col += 8 * fq;
            const int pi0 = ((P & 63) + 8 * fq) >> 1;
#pragma unroll
            for (int ai = 0; ai < 2; ++ai) {
                f32x4 rc4[4], rs4[4];
                if (kind == 3) {
#pragma unroll
                    for (int m = 0; m < 4; ++m) { const int t = (row0 + ai * 128 + m * 16) & (SEQ - 1); rc4[m] = *(const f32x4*)(ropec + t * 32 + pi0); rs4[m] = *(const f32x4*)(ropes + t * 32 + pi0); }
                }
#pragma unroll
                for (int m = 0; m < 4; ++m) {
                    const int row = row0 + ai * 128 + m * 16; const float r = rv[ai][m];
                    float v[8];
#pragma unroll
                    for (int j = 0; j < 4; ++j) { v[j] = acc[ai][bj][m][0][j] * r; v[4 + j] = acc[ai][bj][m][1][j] * r; }
                    if (kind == 1) {
#pragma unroll
                        for (int j = 0; j < 8; ++j) v[j] = gelu_f(v[j]);
                    } else if (kind == 3) {
                        const f32x4 c4 = rc4[m], s4 = rs4[m];
#pragma unroll
                        for (int j = 0; j < 4; ++j) { const float x1 = v[2 * j], x2 = v[2 * j + 1]; v[2 * j] = x1 * c4[j] - x2 * s4[j]; v[2 * j + 1] = x1 * s4[j] + x2 * c4[j]; }
                    }
                    u32x4 w; w.x = cvtpk(v[0] * sc, v[1] * sc); w.y = cvtpk(v[2] * sc, v[3] * sc); w.z = cvtpk(v[4] * sc, v[5] * sc); w.w = cvtpk(v[6] * sc, v[7] * sc);
                    *(u32x4*)(dst + (size_t)(row + rowadd) * ld + col) = w;
                }
            }
        }
    }
};
struct EpiRowScale {
    static constexpr bool PERM = true, AFTER_DRAIN = false;
    bf16* O; int ldc; const float* rs;
    __device__ __forceinline__ void operator()(const f32x4 (&acc)[2][2][4][2], const Unit& u, int wr, int wc, int fr, int fq) const {
        const int row0 = u.pm * 256 + wr * 64 + fr;
        float rv[2][4];
#pragma unroll
        for (int ai = 0; ai < 2; ++ai)
#pragma unroll
            for (int m = 0; m < 4; ++m) rv[ai][m] = rs[row0 + ai * 128 + m * 16];
#pragma unroll
        for (int ai = 0; ai < 2; ++ai)
#pragma unroll
            for (int m = 0; m < 4; ++m) { const int row = row0 + ai * 128 + m * 16; const float r = rv[ai][m];
#pragma unroll
                for (int bj = 0; bj < 2; ++bj) { const int col = u.pn * 256 + bj * 128 + wc * 32 + 8 * fq; const f32x4 a = acc[ai][bj][m][0] * r, b = acc[ai][bj][m][1] * r;
                    u32x4 w; w.x = cvtpk(a[0], a[1]); w.y = cvtpk(a[2], a[3]); w.z = cvtpk(b[0], b[1]); w.w = cvtpk(b[2], b[3]);
                    *(u32x4*)(O + (size_t)row * ldc + col) = w; } }
    }
};
struct EpiGate {
    static constexpr bool PERM = true, AFTER_DRAIN = false;
    unsigned char* g0; unsigned char* g1; unsigned char* g2; unsigned char* g3; const float* rinv;
    __device__ __forceinline__ void operator()(const f32x4 (&acc)[2][2][4][2], const Unit& u, int wr, int wc, int fr, int fq) const {
        const int n = u.pn >> 2, e0 = (u.pn & 3) * 256; unsigned char* G = n == 0 ? g0 : n == 1 ? g1 : n == 2 ? g2 : g3;
        const int row0 = u.pm * 256 + wr * 64 + fr;
        float rv[2][4];
#pragma unroll
        for (int ai = 0; ai < 2; ++ai)
#pragma unroll
            for (int m = 0; m < 4; ++m) rv[ai][m] = rinv[row0 + ai * 128 + m * 16];
#pragma unroll
        for (int ai = 0; ai < 2; ++ai)
#pragma unroll
            for (int m = 0; m < 4; ++m) { const int row = row0 + ai * 128 + m * 16; const float r = rv[ai][m];
#pragma unroll
                for (int bj = 0; bj < 2; ++bj) { const int col = e0 + bj * 128 + wc * 32 + 8 * fq; const f32x4 a = acc[ai][bj][m][0] * r, b = acc[ai][bj][m][1] * r;
                    unsigned q[8];
#pragma unroll
                    for (int j = 0; j < 4; ++j) { q[j] = (unsigned)(sigm(a[j]) * 255.f + 0.5f); q[4 + j] = (unsigned)(sigm(b[j]) * 255.f + 0.5f); }
                    u32x2 w; w.x = q[0] | (q[1] << 8) | (q[2] << 16) | (q[3] << 24); w.y = q[4] | (q[5] << 8) | (q[6] << 16) | (q[7] << 24);
                    *(u32x2*)(G + (size_t)row * 1024 + col) = w; } }
    }
};
struct EpiMerge {
    static constexpr bool PERM = true, AFTER_DRAIN = false;
    const unsigned char* g0; const unsigned char* g1; const unsigned char* g2; const unsigned char* g3; bf16* merged;
    __device__ __forceinline__ void operator()(const f32x4 (&acc)[2][2][4][2], const Unit& u, int wr, int wc, int fr, int fq) const {
        const int n = u.pn >> 2, pn = u.pn & 3, pm = u.pm & 63; const unsigned char* G = n == 0 ? g0 : n == 1 ? g1 : n == 2 ? g2 : g3;
        const int row0 = pm * 256 + wr * 64 + fr; const int col0 = pn * 256 + wc * 32 + 8 * fq;
#pragma unroll
        for (int ai = 0; ai < 2; ++ai) {
            u32x2 gv[4][2]; u32x4 pv[4][2];
#pragma unroll
            for (int m = 0; m < 4; ++m)
#pragma unroll
                for (int bj = 0; bj < 2; ++bj) { const size_t off = (size_t)(row0 + ai * 128 + m * 16) * 1024 + col0 + bj * 128; gv[m][bj] = *(const u32x2*)(G + off); if (n > 0) pv[m][bj] = *(const u32x4*)(merged + off); }
#pragma unroll
            for (int m = 0; m < 4; ++m)
#pragma unroll
                for (int bj = 0; bj < 2; ++bj) { const size_t off = (size_t)(row0 + ai * 128 + m * 16) * 1024 + col0 + bj * 128;
                    const u32x2 g = gv[m][bj]; const f32x4 a = acc[ai][bj][m][0] * (1.f / 255.f), b = acc[ai][bj][m][1] * (1.f / 255.f);
                    float v[8] = {a[0] * (float)(g.x & 255u), a[1] * (float)((g.x >> 8) & 255u), a[2] * (float)((g.x >> 16) & 255u), a[3] * (float)(g.x >> 24),
                                  b[0] * (float)(g.y & 255u), b[1] * (float)((g.y >> 8) & 255u), b[2] * (float)((g.y >> 16) & 255u), b[3] * (float)(g.y >> 24)};
                    if (n > 0) { const u32x4 p = pv[m][bj];
                        v[0] += bflo(p.x); v[1] += bfhi(p.x); v[2] += bflo(p.y); v[3] += bfhi(p.y); v[4] += bflo(p.z); v[5] += bfhi(p.z); v[6] += bflo(p.w); v[7] += bfhi(p.w); }
                    u32x4 w; w.x = cvtpk(v[0], v[1]); w.y = cvtpk(v[2], v[3]); w.z = cvtpk(v[4], v[5]); w.w = cvtpk(v[6], v[7]);
                    *(u32x4*)(merged + off) = w; }
        }
    }
};
struct MergeOrder {
    StaticOrder base;
    __device__ void init(int G, int c) { base.init(NT, DM, G, c); }
    __device__ bool next(int i, Unit& u) const { if (!base.next(i >> 2, u)) return false; const int n = i & 3; u.pm += 64 * n; u.pn += 4 * n; return true; }
    __device__ __forceinline__ void a_ready(const Unit&) const {}
    __device__ __forceinline__ void done(const Unit&) const {}
};
struct EpiOut {
    static constexpr bool PERM = true, AFTER_DRAIN = false;
    bf16* out; float* part;
    __device__ __forceinline__ void operator()(const f32x4 (&acc)[2][2][4][2], const Unit& u, int wr, int wc, int fr, int fq) const {
        const int row0 = u.pm * 256 + wr * 64 + fr; const int col0 = u.pn * 256 + wc * 32 + 8 * fq;
#pragma unroll
        for (int ai = 0; ai < 2; ++ai)
#pragma unroll
            for (int m = 0; m < 4; ++m) { const int row = row0 + ai * 128 + m * 16; float ss = 0.f;
#pragma unroll
                for (int bj = 0; bj < 2; ++bj) { const f32x4 a = acc[ai][bj][m][0], b = acc[ai][bj][m][1];
                    ss += ((a[0] * a[0] + a[1] * a[1]) + (a[2] * a[2] + a[3] * a[3])) + ((b[0] * b[0] + b[1] * b[1]) + (b[2] * b[2] + b[3] * b[3]));
                    u32x4 w; w.x = cvtpk(a[0], a[1]); w.y = cvtpk(a[2], a[3]); w.z = cvtpk(b[0], b[1]); w.w = cvtpk(b[2], b[3]);
                    *(u32x4*)(out + (size_t)row * 1024 + col0 + bj * 128) = w; }
                ss += __shfl_xor(ss, 16); ss += __shfl_xor(ss, 32);
                if (fq == 0) part[(size_t)row * 16 + u.pn * 4 + wc] = ss; }
    }
};
}


template <int HD> struct AT {
    static constexpr int ROWB = HD * 2, CPR = HD / 8, NDS = HD / 16, NDB = HD / 32, TILEB = 64 * ROWB, NLD = TILEB / (512 * 16);
    static constexpr int BUFB = 2 * TILEB;
    static constexpr int NB = HD == 64 ? 5 : 3, DEPTH = NB - 1;
    static constexpr int CKOFF = NB * BUFB;
    static constexpr int STGOFF = 0;
    static constexpr int STGROW = ROWB + 16, STGB = 32 * STGROW;
    __device__ static __forceinline__ int fk(int row) { return HD == 64 ? ((row >> 1) & 7) : (row & 15); }
    __device__ static __forceinline__ int fv(int row) { return HD == 64 ? ((row >> 1) & 1) : (row & 3); }
};
typedef short v4i16_t __attribute__((ext_vector_type(4)));
__device__ __forceinline__ s16x4 vtr(const LAS unsigned char* p) { return __builtin_bit_cast(s16x4, __builtin_amdgcn_ds_read_tr16_b64_v4i16((LAS v4i16_t*)p)); }

template <int HD> __device__ __forceinline__ void tile_load(const bf16* g, int ld, int row0, u32x4 (&r)[AT<HD>::NLD], int tid) {
#pragma unroll
    for (int i = 0; i < AT<HD>::NLD; ++i) { const int idx = tid + 512 * i, row = idx / AT<HD>::CPR, ch = idx % AT<HD>::CPR; r[i] = *(const u32x4*)(g + (size_t)(row0 + row) * ld + ch * 8); }
}
template <int HD> __device__ __forceinline__ void tile_store_k(LAS unsigned char* kt, const u32x4 (&r)[AT<HD>::NLD], int tid) {
#pragma unroll
    for (int i = 0; i < AT<HD>::NLD; ++i) { const int idx = tid + 512 * i, row = idx / AT<HD>::CPR, ch = idx % AT<HD>::CPR; *(LAS u32x4*)(kt + row * AT<HD>::ROWB + ((ch ^ AT<HD>::fk(row)) << 4)) = r[i]; }
}
template <int HD> __device__ __forceinline__ void tile_store_v(LAS unsigned char* vt, const u32x4 (&r)[AT<HD>::NLD], int tid) {
#pragma unroll
    for (int i = 0; i < AT<HD>::NLD; ++i) { const int idx = tid + 512 * i, row = idx / AT<HD>::CPR, ch = idx % AT<HD>::CPR; *(LAS u32x4*)(vt + row * AT<HD>::ROWB + ((((ch >> 2) ^ AT<HD>::fv(row))) << 6) + ((ch & 3) << 4)) = r[i]; }
}
template <int HD> __device__ __forceinline__ void qk_tile(const LAS unsigned char* kt, const bf16x8 (&qf)[HD / 16], f32x16& s0, f32x16& s1, int lane) {
    const int r31 = lane & 31, hi = lane >> 5; const int f = AT<HD>::fk(r31); const LAS unsigned char* kb = kt + r31 * AT<HD>::ROWB;
    if constexpr (HD == 64) {
        bf16x8 k0[4], k1[4];
#pragma unroll
        for (int ds = 0; ds < 4; ++ds) { const int off = ((2 * ds + hi) ^ f) << 4; k0[ds] = *(const LAS bf16x8*)(kb + off); k1[ds] = *(const LAS bf16x8*)(kb + 32 * AT<HD>::ROWB + off); }
        __builtin_amdgcn_sched_barrier(0);
#pragma unroll
        for (int ds = 0; ds < 4; ++ds) {
            s0 = __builtin_amdgcn_mfma_f32_32x32x16_bf16(k0[ds], qf[ds], s0, 0, 0, 0);
            s1 = __builtin_amdgcn_mfma_f32_32x32x16_bf16(k1[ds], qf[ds], s1, 0, 0, 0);
        }
    } else {
#pragma unroll
        for (int ds = 0; ds < HD / 16; ++ds) {
            const int off = ((2 * ds + hi) ^ f) << 4;
            const bf16x8 k0 = *(const LAS bf16x8*)(kb + off), k1 = *(const LAS bf16x8*)(kb + 32 * AT<HD>::ROWB + off);
            s0 = __builtin_amdgcn_mfma_f32_32x32x16_bf16(k0, qf[ds], s0, 0, 0, 0);
            s1 = __builtin_amdgcn_mfma_f32_32x32x16_bf16(k1, qf[ds], s1, 0, 0, 0);
        }
    }
}
template <int HD> __device__ __forceinline__ void v_load(const LAS unsigned char* vt, bf16x8 (&vf)[HD / 8], int lane) {
    const int hi = lane >> 5, q = (lane >> 2) & 3; const int fl = HD == 64 ? (q >> 1) : q;
    const LAS unsigned char* vb = vt + (4 * hi + q) * AT<HD>::ROWB + 32 * ((lane >> 4) & 1) + 8 * (lane & 3);
#pragma unroll
    for (int db = 0; db < HD / 32; ++db) {
        const LAS unsigned char* vd = vb + ((db ^ fl) << 6);
#pragma unroll
        for (int ks = 0; ks < 4; ++ks) {
            const s16x4 lo = vtr(vd + (16 * ks) * AT<HD>::ROWB), hh = vtr(vd + (16 * ks + 8) * AT<HD>::ROWB);
            vf[db * 4 + ks] = (bf16x8){lo[0], lo[1], lo[2], lo[3], hh[0], hh[1], hh[2], hh[3]};
        }
    }
}
__device__ __forceinline__ void p_pack(const f32x16& p0, const f32x16& p1, bf16x8 (&pk)[4]) {
#pragma unroll
    for (int s = 0; s < 2; ++s) {
        u32x4 a, b;
        a.x = cvtpk(p0[8 * s + 0], p0[8 * s + 1]); a.y = cvtpk(p0[8 * s + 2], p0[8 * s + 3]); a.z = cvtpk(p0[8 * s + 4], p0[8 * s + 5]); a.w = cvtpk(p0[8 * s + 6], p0[8 * s + 7]);
        b.x = cvtpk(p1[8 * s + 0], p1[8 * s + 1]); b.y = cvtpk(p1[8 * s + 2], p1[8 * s + 3]); b.z = cvtpk(p1[8 * s + 4], p1[8 * s + 5]); b.w = cvtpk(p1[8 * s + 6], p1[8 * s + 7]);
        pk[s] = __builtin_bit_cast(bf16x8, a); pk[2 + s] = __builtin_bit_cast(bf16x8, b);
    }
}
template <int HD> __device__ __forceinline__ void pv_mma(const bf16x8 (&vf)[HD / 8], const bf16x8 (&pk)[4], f32x16 (&o)[HD / 32]) {
    __builtin_amdgcn_s_setprio(1);
#pragma unroll
    for (int db = 0; db < HD / 32; ++db)
#pragma unroll
        for (int ks = 0; ks < 4; ++ks) o[db] = __builtin_amdgcn_mfma_f32_32x32x16_bf16(vf[db * 4 + ks], pk[ks], o[db], 0, 0, 0);
    __builtin_amdgcn_s_setprio(0);
}
template <int HD> __device__ __forceinline__ void pv_tile(const LAS unsigned char* vt, const f32x16& p0, const f32x16& p1, f32x16 (&o)[HD / 32], int lane) {
    bf16x8 vf[HD / 8], pk[4]; v_load<HD>(vt, vf, lane); p_pack(p0, p1, pk); pv_mma<HD>(vf, pk, o);
}
template <int HD, bool EARLYV> __device__ __forceinline__ void softmax_pv(const LAS unsigned char* vt, f32x16& s0, f32x16& s1, f32x16 (&o)[HD / 32], float& m, float& l, int lane) {
    bf16x8 vf[HD / 8];
    if (EARLYV) { v_load<HD>(vt, vf, lane); __builtin_amdgcn_sched_barrier(0); }
    float mx = fmaxf(s0[0], s1[0]);
#pragma unroll
    for (int r = 1; r < 16; ++r) mx = fmaxf(mx, fmaxf(s0[r], s1[r]));
    mx = fmaxf(mx, __shfl_xor(mx, 32));
    const float mn = fmaxf(m, mx), ms = (mn == -INFINITY) ? 0.f : mn;
    const float al = ex2(m - ms); m = mn;
    float ps = 0.f;
#pragma unroll
    for (int r = 0; r < 16; ++r) { s0[r] = ex2(s0[r] - ms); s1[r] = ex2(s1[r] - ms); ps += s0[r] + s1[r]; }
    l = l * al + ps;
    if (__any(al != 1.f)) {
#pragma unroll
        for (int db = 0; db < HD / 32; ++db) o[db] *= al;
    }
    bf16x8 pk[4]; p_pack(s0, s1, pk);
    if (!EARLYV) v_load<HD>(vt, vf, lane);
    pv_mma<HD>(vf, pk, o);
}
__device__ __forceinline__ void glds16(const void* gsrc, unsigned lds_dst) { unsigned keep;
    asm volatile("s_mov_b32 %0, m0\n\ts_mov_b32 m0, %2\n\ts_nop 0\n\tglobal_load_lds_dwordx4 %1, off\n\ts_mov_b32 m0, %0" : "=&s"(keep) : "v"(gsrc), "s"(lds_dst) : "memory"); }
__device__ __forceinline__ void glds4(const void* gsrc, unsigned lds_dst) { unsigned keep;
    asm volatile("s_mov_b32 %0, m0\n\ts_mov_b32 m0, %2\n\ts_nop 0\n\tglobal_load_lds_dword %1, off\n\ts_mov_b32 m0, %0" : "=&s"(keep) : "v"(gsrc), "s"(lds_dst) : "memory"); }
template <int N> __device__ __forceinline__ void wait_bar() { asm volatile("s_waitcnt vmcnt(%0) lgkmcnt(0)\n\ts_barrier" :: "n"(N) : "memory"); }
typedef float f32x2 __attribute__((ext_vector_type(2)));
__device__ __forceinline__ float fadd_s(float a, float b) { float r; asm("v_add_f32_e32 %0, %1, %2" : "=v"(r) : "v"(a), "v"(b)); return r; }
__device__ __forceinline__ float max3(float a, float b, float c) { return __builtin_fmaxf(__builtin_fmaxf(a, b), c); }
__device__ __forceinline__ float xmax32(float v) { auto rr = __builtin_amdgcn_permlane32_swap(__float_as_uint(v), __float_as_uint(v), false, false); return __builtin_fmaxf(__uint_as_float(rr[0]), __uint_as_float(rr[1])); }
constexpr float SM_THR = 16.f;
template <bool CK> __device__ __forceinline__ void qk64(const LAS unsigned char* kt, const LAS unsigned char* kx, const bf16x8 (&qf)[4], const bf16x8& qx, f32x16& s0, f32x16& s1, int lane) {
    const int r31 = lane & 31, hi = lane >> 5; const int fsw = (r31 >> 1) & 7; const LAS unsigned char* kb = kt + r31 * 128;
    bf16x8 k0[4], k1[4], kx0 = {}, kx1 = {};
#pragma unroll
    for (int ds = 0; ds < 4; ++ds) { const int off = ((2 * ds + hi) ^ fsw) << 4; k0[ds] = *(const LAS bf16x8*)(kb + off); k1[ds] = *(const LAS bf16x8*)(kb + 32 * 128 + off); }
    if (CK) { kx0 = *(const LAS bf16x8*)(kx + r31 * 32 + hi * 16); kx1 = *(const LAS bf16x8*)(kx + 1024 + r31 * 32 + hi * 16); }
    __builtin_amdgcn_s_setprio(1);
    { const f32x16 z = {}; s0 = __builtin_amdgcn_mfma_f32_32x32x16_bf16(k0[0], qf[0], z, 0, 0, 0); s1 = __builtin_amdgcn_mfma_f32_32x32x16_bf16(k1[0], qf[0], z, 0, 0, 0); }
#pragma unroll
    for (int ds = 1; ds < 4; ++ds) { s0 = __builtin_amdgcn_mfma_f32_32x32x16_bf16(k0[ds], qf[ds], s0, 0, 0, 0); s1 = __builtin_amdgcn_mfma_f32_32x32x16_bf16(k1[ds], qf[ds], s1, 0, 0, 0); }
    if (CK) { s0 = __builtin_amdgcn_mfma_f32_32x32x16_bf16(kx0, qx, s0, 0, 0, 0); s1 = __builtin_amdgcn_mfma_f32_32x32x16_bf16(kx1, qx, s1, 0, 0, 0); }
    __builtin_amdgcn_s_setprio(0);
}
__device__ __forceinline__ void pv64(const LAS unsigned char* vt, const bf16x8 (&pk)[4], f32x16 (&o)[2], int lane) { bf16x8 vf[8]; v_load<64>(vt, vf, lane); pv_mma<64>(vf, pk, o); }
template <int NDB, class F> __device__ __forceinline__ bool smx(f32x16& s0, f32x16& s1, bf16x8 (&pk)[4], f32x16 (&o)[NDB], float& R, f32x2& l2, int& init, const F& f, int j, int lane) {
    const int hi = lane >> 5;
    const bool ok = f.lane_ok(j);
    if (f.needmask(j)) f.mask(s0, s1, j, hi);
    if (__any(R != 0.f)) { s0 -= R; s1 -= R; }
    float a = max3(s0[0], s0[1], s1[0]), b = max3(s0[2], s0[3], s1[1]); a = max3(a, s1[2], s1[3]);
#pragma unroll
    for (int r = 4; r < 16; r += 4) { a = max3(a, s0[r], s0[r + 1]); b = max3(b, s0[r + 2], s0[r + 3]); a = max3(a, s1[r], s1[r + 1]); b = max3(b, s1[r + 2], s1[r + 3]); }
    float rm = xmax32(__builtin_fmaxf(a, b));
    if (!ok) rm = -INFINITY;
    const bool fin = rm > -INFINITY;
    if (__all(rm < -140.f && (init || !fin))) return false;
    const bool need = (rm > SM_THR) || (!init && fin && rm < -SM_THR);
    if (__any(need)) {
        const float d = need ? rm : 0.f; R += d; s0 -= d; s1 -= d;
        const float fs = (need && init) ? ex2(-d) : 1.f; l2 *= fs;
#pragma unroll
        for (int db = 0; db < NDB; ++db) o[db] *= fs;
    }
    init |= fin ? 1 : 0;
#pragma unroll
    for (int r = 0; r < 16; ++r) { s0[r] = ex2(s0[r]); s1[r] = ex2(s1[r]); }
    f32x2 acc;
    { float a0 = fadd_s(s0[0], s0[1]), a1 = fadd_s(s1[0], s1[1]), a2 = fadd_s(s0[2], s0[3]), a3 = fadd_s(s1[2], s1[3]);
#pragma unroll
      for (int r = 4; r < 16; r += 4) { a0 = fadd_s(a0, s0[r]); a1 = fadd_s(a1, s1[r]); a2 = fadd_s(a2, s0[r + 1]); a3 = fadd_s(a3, s1[r + 1]); a0 = fadd_s(a0, s0[r + 2]); a1 = fadd_s(a1, s1[r + 2]); a2 = fadd_s(a2, s0[r + 3]); a3 = fadd_s(a3, s1[r + 3]); }
      acc.x = fadd_s(a0, a1); acc.y = fadd_s(a2, a3); }
    p_pack(s0, s1, pk);
    if (__any(!ok)) {
        const bf16x8 zz = {};
#pragma unroll
        for (int i = 0; i < 4; ++i) pk[i] = ok ? pk[i] : zz;
        acc = ok ? acc : (f32x2){0.f, 0.f};
    }
    l2 += acc;
    return true;
}
__device__ __forceinline__ void bar_lds() { asm volatile("s_waitcnt lgkmcnt(0)\n\ts_barrier" ::: "memory"); }
template <bool CK, bool DESC, class F>
__device__ __forceinline__ void attn_run64(LAS unsigned char* lds, const bf16* Kg, int ldk, const bf16* Vg, int ldv, const bf16* kxg, const bf16x8& qx, unsigned tmask,
                                           const bf16x8 (&qf)[4], f32x16 (&o)[2], float& l, const F& f, int tid, int lane) {
    l = 0.f;
    if (tmask == 0u) return;
    constexpr int NB = 5, LPT = 2 + (CK ? 1 : 0), TILEB = AT<64>::TILEB, BUFB = AT<64>::BUFB, CKOFF = AT<64>::CKOFF;
    const int wid = __builtin_amdgcn_readfirstlane(tid >> 6);
    const unsigned lds0 = (unsigned)(size_t)lds;
    const int r = 8 * wid + (lane >> 3), pc = lane & 7;
    const int koff = r * ldk + ((pc ^ AT<64>::fk(r)) << 3), voff = r * ldv + (((((pc >> 2) ^ AT<64>::fv(r)) << 2) | (pc & 3)) << 3);
    unsigned remi = tmask; int lastj = 0, ib = 0;
#define ATTN_ISSUE() do { \
        if (remi) { if (DESC) { lastj = 31 - __builtin_clz(remi); remi &= ~(1u << lastj); } else { lastj = __builtin_ctz(remi); remi &= remi - 1; } } \
        const unsigned kdst_ = lds0 + ib * BUFB + wid * 1024; \
        glds16(Kg + (size_t)(64 * lastj) * ldk + koff, (unsigned)__builtin_amdgcn_readfirstlane(kdst_)); \
        glds16(Vg + (size_t)(64 * lastj) * ldv + voff, (unsigned)__builtin_amdgcn_readfirstlane(kdst_ + TILEB)); \
        if (CK) glds4((const unsigned char*)kxg + (size_t)(64 * lastj) * 32 + wid * 256 + lane * 4, (unsigned)__builtin_amdgcn_readfirstlane(lds0 + CKOFF + ib * 2048 + wid * 256)); \
        ib = ib + 1 == NB ? 0 : ib + 1; } while (0)
    ATTN_ISSUE(); ATTN_ISSUE(); ATTN_ISSUE(); ATTN_ISSUE();
    unsigned remq = tmask; int cb = 0, jc = 0;
    float R = 0.f; f32x2 l2 = {0.f, 0.f}; int init = 0;
    while (remq) {
        wait_bar<3 * LPT>();
        ATTN_ISSUE();
        if (DESC) { jc = 31 - __builtin_clz(remq); remq &= ~(1u << jc); } else { jc = __builtin_ctz(remq); remq &= remq - 1; }
        if (f.active(jc)) {
            f32x16 s0, s1; bf16x8 pk[4], vf[8];
            qk64<CK>(lds + cb * BUFB, lds + CKOFF + cb * 2048, qf, qx, s0, s1, lane);
            v_load<64>(lds + cb * BUFB + TILEB, vf, lane);
            if (smx<2>(s0, s1, pk, o, R, l2, init, f, jc, lane)) pv_mma<64>(vf, pk, o);
        }
        cb = cb + 1 == NB ? 0 : cb + 1;
    }
    wait_bar<0>();
    l = l2.x + l2.y;
#undef ATTN_ISSUE
}
template <int HD, class F>
__device__ __forceinline__ void attn_run128(LAS unsigned char* lds, const bf16* Kg, int ldk, const bf16* Vg, int ldv, unsigned tmask,
                                            const bf16x8 (&qf)[HD / 16], f32x16 (&o)[HD / 32], float& l, const F& f, int tid, int lane) {
    l = 0.f;
    if (tmask == 0u) return;
    constexpr int NB = AT<HD>::NB, D = AT<HD>::DEPTH, PPW = HD / 64, LPT = 2 * PPW;
    const int wid = __builtin_amdgcn_readfirstlane(tid >> 6);
    const unsigned lds0 = (unsigned)(size_t)lds;
    int koff[PPW], voff[PPW];
#pragma unroll
    for (int p = 0; p < PPW; ++p) { const int piece = wid * PPW + p; const int r = 4 * piece + (lane >> 4); const int pc = lane & 15;
        koff[p] = r * ldk + ((pc ^ AT<HD>::fk(r)) << 3); const int blk = (pc >> 2) ^ AT<HD>::fv(r); voff[p] = r * ldv + (((blk << 2) | (pc & 3)) << 3); }
    unsigned remi = tmask; int lastj = 0, ib = 0;
#define ATTN_ISSUE() do { \
        if (remi) { lastj = __builtin_ctz(remi); remi &= remi - 1; } \
        const unsigned kdst_ = lds0 + ib * AT<HD>::BUFB + wid * PPW * 1024, vdst_ = kdst_ + AT<HD>::TILEB; \
        _Pragma("unroll") for (int p = 0; p < PPW; ++p) { glds16(Kg + (size_t)(64 * lastj) * ldk + koff[p], (unsigned)__builtin_amdgcn_readfirstlane(kdst_ + p * 1024)); \
            glds16(Vg + (size_t)(64 * lastj) * ldv + voff[p], (unsigned)__builtin_amdgcn_readfirstlane(vdst_ + p * 1024)); } \
        ib = ib + 1 == NB ? 0 : ib + 1; } while (0)
#pragma unroll
    for (int k = 0; k < D; ++k) ATTN_ISSUE();
    unsigned remp = tmask; int pb = 0; float R = 0.f; f32x2 l2 = {0.f, 0.f}; int init = 0;
    while (remp) {
        wait_bar<(D - 1) * LPT>();
        ATTN_ISSUE();
        const int j = __builtin_ctz(remp); remp &= remp - 1;
        if (f.active(j)) { const LAS unsigned char* kt = lds + pb * AT<HD>::BUFB; f32x16 s0 = {}, s1 = {}; bf16x8 pk[4]; qk_tile<HD>(kt, qf, s0, s1, lane);
            if (smx<HD / 32>(s0, s1, pk, o, R, l2, init, f, j, lane)) { bf16x8 vf[HD / 8]; v_load<HD>(kt + AT<HD>::TILEB, vf, lane); pv_mma<HD>(vf, pk, o); } }
        pb = pb + 1 == NB ? 0 : pb + 1;
    }
    wait_bar<0>();
    l = l2.x + l2.y;
#undef ATTN_ISSUE
}
template <int HD> __device__ __forceinline__ void attn_store(LAS unsigned char* stg, const f32x16 (&o)[HD / 32], const bf16* zg, int ldz, bf16* outg, int ldo, int lane) {
    const int q = lane & 31, hi = lane >> 5;
#pragma unroll
    for (int db = 0; db < HD / 32; ++db)
#pragma unroll
        for (int g = 0; g < 4; ++g) { u32x2 w; w.x = cvtpk(o[db][4 * g], o[db][4 * g + 1]); w.y = cvtpk(o[db][4 * g + 2], o[db][4 * g + 3]);
            *(LAS u32x2*)(stg + q * AT<HD>::STGROW + (32 * db + 8 * g + 4 * hi) * 2) = w; }
    constexpr int CPR = AT<HD>::CPR, RPP = 64 / CPR, NIT = 32 / RPP;
    u32x4 zs[NIT];
#pragma unroll
    for (int it = 0; it < NIT; ++it) { const int row = it * RPP + lane / CPR, ch = lane % CPR; zs[it] = *(const u32x4*)(zg + (size_t)row * ldz + ch * 8); }
#pragma unroll
    for (int it = 0; it < NIT; ++it) { const int row = it * RPP + lane / CPR, ch = lane % CPR;
        const u32x4 v = *(const LAS u32x4*)(stg + row * AT<HD>::STGROW + ch * 16); const u32x4 z = zs[it];
        u32x4 w; w.x = cvtpk(bflo(v.x) * silu_f(bflo(z.x)), bfhi(v.x) * silu_f(bfhi(z.x))); w.y = cvtpk(bflo(v.y) * silu_f(bflo(z.y)), bfhi(v.y) * silu_f(bfhi(z.y)));
        w.z = cvtpk(bflo(v.z) * silu_f(bflo(z.z)), bfhi(v.z) * silu_f(bfhi(z.z))); w.w = cvtpk(bflo(v.w) * silu_f(bflo(z.w)), bfhi(v.w) * silu_f(bfhi(z.w)));
        *(u32x4*)(outg + (size_t)row * ldo + ch * 8) = w; }
}
template <int HD> __device__ __forceinline__ void load_q(const bf16* qrow, bf16x8 (&qf)[HD / 16], int hi) {
#pragma unroll
    for (int ds = 0; ds < HD / 16; ++ds) qf[ds] = *(const bf16x8*)(qrow + 16 * ds + 8 * hi);
}
__device__ __forceinline__ float lsum_inv(float l) { const float lt = l + __shfl_xor(l, 32); return lt > 0.f ? 1.f / lt : 0.f; }

struct FNone { __device__ __forceinline__ bool active(int) const { return true; } __device__ __forceinline__ bool lane_ok(int) const { return true; } __device__ __forceinline__ bool needmask(int) const { return false; }
    __device__ __forceinline__ void mask(f32x16&, f32x16&, int, int) const {} };
struct FForget {
    int tq, qmin, qmax;
    __device__ __forceinline__ bool active(int j) const { return 64 * j <= qmax; }
    __device__ __forceinline__ bool lane_ok(int) const { return true; }
    __device__ __forceinline__ bool needmask(int j) const { return 64 * j + 63 > qmin; }
    __device__ __forceinline__ void mask(f32x16& s0, f32x16& s1, int j, int hi) const {
        const int kb = 64 * j;
#pragma unroll
        for (int r = 0; r < 16; ++r) { const int k0 = kb + crow(r, hi); if (k0 > tq) s0[r] = -INFINITY; if (k0 + 32 > tq) s1[r] = -INFINITY; }
    }
};
struct FSelWin {
    unsigned sel; int tq, cur, mode, lo;
    __device__ __forceinline__ bool active(int j) const { return mode ? true : (__any((sel >> j) & 1u) != 0); }
    __device__ __forceinline__ bool lane_ok(int j) const { return mode ? true : (((sel >> j) & 1u) != 0u); }
    __device__ __forceinline__ bool needmask(int j) const { return (j == cur) || (mode && j == cur - 4); }
    __device__ __forceinline__ void mask(f32x16& s0, f32x16& s1, int j, int hi) const {
        const int kb = 64 * j;
#pragma unroll
        for (int r = 0; r < 16; ++r) { const int k0 = kb + crow(r, hi); if (k0 > tq || k0 <= lo) s0[r] = -INFINITY; if (k0 + 32 > tq || k0 + 32 <= lo) s1[r] = -INFINITY; }
    }
};

struct Ptrs {
    const float* in[21]; unsigned char* out; unsigned char* ws;
};
__device__ __forceinline__ void fa_item(const Ptrs& P, LAS unsigned char* lds, int b, int h, int qt, int tid, int lane, int wid) {
    bf16* CQ = (bf16*)slot_ptr(P.ws, P.out, SL_CQ); const bf16* CK = (const bf16*)slot_ptr(P.ws, P.out, SL_CK); const bf16* CV = (const bf16*)slot_ptr(P.ws, P.out, SL_CV); const bf16* CZ = (const bf16*)slot_ptr(P.ws, P.out, SL_CZ);
    const bf16* KX = (const bf16*)(P.ws + WS_KX) + (size_t)(b * 8 + h) * SEQ * 16; const bf16* QX = (const bf16*)(P.ws + WS_QX) + (size_t)(b * 8 + h) * SEQ * 8;
    const int hi = lane >> 5, t0 = 256 * qt + 32 * wid, tq = t0 + (lane & 31);
    const size_t rowq = (size_t)(b * SEQ + tq) * 512 + h * 64;
    bf16x8 qf[4]; load_q<64>(CQ + rowq, qf, hi);
    f32x16 o[2] = {}; float l = 0.f;
    bf16x8 qx = {}; if (hi == 0) qx = *(const bf16x8*)(QX + (size_t)tq * 8);
    FForget f; f.tq = tq; f.qmin = t0; f.qmax = t0 + 31;
    const int ntile = 4 * qt + 4; const unsigned tmask = ntile >= 32 ? 0xffffffffu : ((1u << ntile) - 1u);
    attn_run64<true, true>(lds, CK + (size_t)b * SEQ * 512 + h * 64, 512, CV + (size_t)b * SEQ * 512 + h * 64, 512, KX, qx, tmask, qf, o, l, f, tid, lane);
    const float li = lsum_inv(l);
    o[0] *= li; o[1] *= li;
    const size_t row0 = (size_t)(b * SEQ + t0) * 512 + h * 64;
    attn_store<64>(lds + AT<64>::STGOFF + wid * AT<64>::STGB, o, CZ + row0, 512, CQ + row0, 512, lane);
}
__device__ __forceinline__ void mem_item(const Ptrs& P, LAS unsigned char* lds, int b, int h, int qt, int tid, int lane, int wid) {
    bf16* MQ = (bf16*)slot_ptr(P.ws, P.out, SL_MQ); const bf16* MZ = (const bf16*)slot_ptr(P.ws, P.out, SL_MZ); const bf16* MKV = (const bf16*)(P.ws + WS_MKV);
    const int hi = lane >> 5, t0 = 256 * qt + 32 * wid, tq = t0 + (lane & 31);
    bf16x8 qf[8]; load_q<128>(MQ + (size_t)(b * SEQ + tq) * 512 + h * 128, qf, hi);
    f32x16 o[4] = {}; float l = 0.f; FNone f; const bf16x8 qx0 = {};
    attn_run128<128>(lds, MKV + (size_t)b * MEMLEN * 1024 + h * 128, 1024, MKV + (size_t)b * MEMLEN * 1024 + 512 + h * 128, 1024, 0xfu, qf, o, l, f, tid, lane);
    const float li = lsum_inv(l);
#pragma unroll
    for (int db = 0; db < 4; ++db) o[db] *= li;
    const size_t row0 = (size_t)(b * SEQ + t0) * 512 + h * 128;
    attn_store<128>(lds + AT<128>::STGOFF + wid * AT<128>::STGB, o, MZ + row0, 512, MQ + row0, 512, lane);
}
constexpr int NSA_IMPQ = 32768;
constexpr int NSA_IMPL = NSA_IMPQ + 32768;
constexpr int NSA_IMPF = NSA_IMPL + 32768;
constexpr int NSA_SEL = NSA_IMPF + 8192;
__device__ __forceinline__ void nsa_item(const Ptrs& P, LAS unsigned char* lds, int b, int kvh, int cur, int tid, int lane, int wid) {
    bf16* BQ = (bf16*)slot_ptr(P.ws, P.out, SL_BQ); const bf16* BZ = (const bf16*)slot_ptr(P.ws, P.out, SL_BZ);
    const bf16* KVS = (const bf16*)(P.ws + WS_KVS); const size_t hoff = (size_t)(b * 2 + kvh) * SEQ * 64;
    const bf16* KS = KVS + 1 * 2 * MiB + hoff; const bf16* KW = KVS + 2 * 2 * MiB + hoff; const bf16* VS = KVS + 4 * 2 * MiB + hoff; const bf16* VW = KVS + 5 * 2 * MiB + hoff;
    const bf16* KCMP = (const bf16*)(P.ws + WS_KCMP) + (size_t)(b * 2 + kvh) * 128 * 64; const bf16* VCMP = (const bf16*)(P.ws + WS_VCMP) + (size_t)(b * 2 + kvh) * 128 * 64;
    const float* SM = (const float*)(P.ws + WS_SM);
    const int hi = lane >> 5, g = wid >> 1, pos = 32 * (wid & 1) + (lane & 31), tq = 64 * cur + pos, hq = kvh * 4 + g;
    const size_t rowq = (size_t)(b * SEQ + tq) * 512 + hq * 64;
    bf16x8 qf[4]; load_q<64>(BQ + rowq, qf, hi);
    const float* gl = SM + (size_t)(b * SEQ + tq) * 32 + hq * 3; const float g0 = gl[0], g12[2] = {gl[1], gl[2]};
    f32x16 res[2] = {};
    {
        const int ntc = (4 * cur + 2) / 64 + 1;
        u32x4 kr[2][1], vr[2][1];
#pragma unroll
        for (int tl = 0; tl < 2; ++tl) if (tl < ntc) { tile_load<64>(KCMP, 64, 64 * tl, kr[tl], tid); tile_load<64>(VCMP, 64, 64 * tl, vr[tl], tid); }
#pragma unroll
        for (int tl = 0; tl < 2; ++tl) if (tl < ntc) { tile_store_k<64>(lds + tl * AT<64>::BUFB, kr[tl], tid); tile_store_v<64>(lds + tl * AT<64>::BUFB + AT<64>::TILEB, vr[tl], tid); }
        __syncthreads();
        f32x16 o[2] = {}; float m = -INFINITY, l = 0.f;
#pragma unroll 1
        for (int tl = 0; tl < ntc; ++tl) {
            f32x16 s0 = {}, s1 = {};
            qk_tile<64>(lds + tl * AT<64>::BUFB, qf, s0, s1, lane);
#pragma unroll
            for (int r = 0; r < 16; ++r) { const int c0 = 64 * tl + crow(r, hi); if (16 * c0 + 31 > tq) s0[r] = -INFINITY; if (16 * (c0 + 32) + 31 > tq) s1[r] = -INFINITY; }
            softmax_pv<64, true>(lds + tl * AT<64>::BUFB + AT<64>::TILEB, s0, s1, o, m, l, lane);
        }
        const float li = lsum_inv(l), ms = (m == -INFINITY) ? 0.f : m;
        res[0] = o[0] * (g0 * li); res[1] = o[1] * (g0 * li);
        LAS float* impq = (LAS float*)(lds + NSA_IMPQ) + g * 2048 + pos; LAS float* impl = (LAS float*)(lds + NSA_IMPL) + g * 2048 + pos;
#pragma unroll 1
        for (int tl = 0; tl < 2; ++tl) {
            f32x16 s0 = {}, s1 = {};
            if (tl < ntc) { qk_tile<64>(lds + tl * AT<64>::BUFB, qf, s0, s1, lane);
#pragma unroll
                for (int r = 0; r < 16; ++r) { const int c0 = 64 * tl + crow(r, hi); s0[r] = (16 * c0 + 31 > tq) ? 0.f : ex2(s0[r] - ms) * li; s1[r] = (16 * (c0 + 32) + 31 > tq) ? 0.f : ex2(s1[r] - ms) * li; } }
#pragma unroll
            for (int gq = 0; gq < 4; ++gq) { const int j0 = 16 * tl + 2 * gq + hi;
                impq[j0 * 64] = (s0[4 * gq] + s0[4 * gq + 1]) + (s0[4 * gq + 2] + s0[4 * gq + 3]); impl[j0 * 64] = s0[4 * gq + 3];
                impq[(j0 + 8) * 64] = (s1[4 * gq] + s1[4 * gq + 1]) + (s1[4 * gq + 2] + s1[4 * gq + 3]); impl[(j0 + 8) * 64] = s1[4 * gq + 3]; }
        }
    }
    __syncthreads();
    {
        const int p = tid >> 3, sub = tid & 7; const int e0 = p * 32 + 4 * sub;
        const LAS float* bq = (const LAS float*)(lds + NSA_IMPQ) + (4 * sub) * 64 + p; const LAS float* bl = (const LAS float*)(lds + NSA_IMPL) + (4 * sub) * 64 + p; LAS float* impf = (LAS float*)(lds + NSA_IMPF) + e0;
        float v[4] = {0.f, 0.f, 0.f, 0.f};
#pragma unroll
        for (int gg = 0; gg < 4; ++gg) { const float cm1 = sub > 0 ? bl[gg * 2048 - 64] : 0.f;
            v[0] += bq[gg * 2048] + cm1; v[1] += bq[gg * 2048 + 64] + bl[gg * 2048]; v[2] += bq[gg * 2048 + 128] + bl[gg * 2048 + 64]; v[3] += bq[gg * 2048 + 192] + bl[gg * 2048 + 128]; }
#pragma unroll
        for (int i = 0; i < 4; ++i) { const int j = 4 * sub + i; if (j == 0 || j == cur || j == cur - 1) v[i] = 1e9f; else if (j > cur) v[i] = -1e30f; }
        *(LAS f32x4*)impf = (f32x4){v[0], v[1], v[2], v[3]};
    }
    __syncthreads();
    {
        const int p = tid >> 3, sub = tid & 7; LAS float* impf = (LAS float*)(lds + NSA_IMPF) + p * 32; LAS unsigned* selw = (LAS unsigned*)(lds + NSA_SEL);
        float mine[4]; int rank[4] = {0, 0, 0, 0};
#pragma unroll
        for (int i = 0; i < 4; ++i) mine[i] = impf[4 * sub + i];
        for (int jj = 0; jj < 32; ++jj) { const float v = impf[jj];
#pragma unroll
            for (int i = 0; i < 4; ++i) { const int j = 4 * sub + i; rank[i] += (v > mine[i] || (v == mine[i] && jj < j)) ? 1 : 0; } }
        unsigned bits = 0u;
#pragma unroll
        for (int i = 0; i < 4; ++i) { const int j = 4 * sub + i; if (rank[i] < 8 && j <= cur) bits |= 1u << j; }
        bits |= __shfl_xor(bits, 1); bits |= __shfl_xor(bits, 2); bits |= __shfl_xor(bits, 4);
        if (sub == 0) selw[p] = bits;
    }
    __syncthreads();
    unsigned selm, uni;
    {
        LAS unsigned* selw = (LAS unsigned*)(lds + NSA_SEL);
        selm = selw[pos];
        unsigned u = selw[lane];
#pragma unroll
        for (int o = 1; o < 64; o <<= 1) u |= __shfl_xor(u, o);
        uni = __builtin_amdgcn_readfirstlane(u);
    }
    const int j0w = cur >= 4 ? cur - 4 : 0; const unsigned hiM = cur >= 31 ? 0xffffffffu : ((2u << cur) - 1u); const unsigned wmask = hiM & ~((1u << j0w) - 1u);
#pragma unroll 1
    for (int br = 0; br < 2; ++br) {
        f32x16 o[2] = {}; float l = 0.f; FSelWin f; f.sel = selm; f.tq = tq; f.cur = cur; f.mode = br; f.lo = br ? tq - 256 : -1; const bf16x8 qx0 = {};
        attn_run64<false, false>(lds, br ? KW : KS, 64, br ? VW : VS, 64, nullptr, qx0, br ? wmask : uni, qf, o, l, f, tid, lane);
        const float li = lsum_inv(l) * (br ? g12[1] : g12[0]); res[0] += o[0] * li; res[1] += o[1] * li;
    }
    const size_t row0 = (size_t)(b * SEQ + 64 * cur + 32 * (wid & 1)) * 512 + hq * 64;
    attn_store<64>(lds + AT<64>::STGOFF + wid * AT<64>::STGB, res, BZ + row0, 512, BQ + row0, 512, lane);
    __syncthreads();
}
__device__ __forceinline__ void cmp_item(const Ptrs& P, LAS unsigned char* lds, int layer, int b, int kvh, int which, int rq, int lane, int wid) {
    const bf16* W = (const bf16*)wbase(P.ws, P.out, layer);
    const bf16* A = (const bf16*)(P.ws + WS_KVS) + (size_t)(which ? 3 : 0) * 2 * MiB + (size_t)(b * 2 + kvh) * SEQ * 64;
    const bf16* W1 = (const bf16*)((const unsigned char*)W + (which ? W_1V : W_1K)); const bf16* W2 = (const bf16*)((const unsigned char*)W + (which ? W_2V : W_2K));
    const float* bias1 = (const float*)(P.ws + WS_BIAS1) + which * 64;
    bf16* O = (bf16*)(P.ws + (which ? WS_VCMP : WS_KCMP)) + (size_t)(b * 2 + kvh) * 128 * 64;
    const int rt = wid & 1, k4 = wid >> 1, c = 32 * rq + 16 * rt + (lane & 15), kq = lane >> 4;
    f32x4 acc[4] = {};
    const bf16* ap = A + (size_t)c * 1024 + 8 * kq + 512 * k4; const bf16* wp = W1 + (size_t)(lane & 15) * 2048 + 8 * kq + 512 * k4;
#pragma unroll 4
    for (int ks = 0; ks < 16; ++ks) {
        const bf16x8 af = *(const bf16x8*)(ap + 32 * ks);
#pragma unroll
        for (int et = 0; et < 4; ++et) { const bf16x8 wf = *(const bf16x8*)(wp + (size_t)et * 16 * 2048 + 32 * ks); acc[et] = __builtin_amdgcn_mfma_f32_16x16x32_bf16(wf, af, acc[et], 0, 0, 0); }
    }
    LAS float* part = (LAS float*)lds + ((k4 * 2 + rt) * 64 + lane) * 16;
#pragma unroll
    for (int et = 0; et < 4; ++et) *(LAS f32x4*)(part + 4 * et) = acc[et];
    __syncthreads();
    if (k4 == 0) {
#pragma unroll
        for (int kk = 1; kk < 4; ++kk)
#pragma unroll
            for (int et = 0; et < 4; ++et) acc[et] += *(const LAS f32x4*)(part + kk * 2 * 64 * 16 + 4 * et);
        bf16x8 hf[2];
#pragma unroll
        for (int s = 0; s < 2; ++s) { u32x4 w; float v[8];
#pragma unroll
            for (int i = 0; i < 4; ++i) { v[i] = silu_f(acc[2 * s][i] + bias1[32 * s + 4 * kq + i]); v[4 + i] = silu_f(acc[2 * s + 1][i] + bias1[32 * s + 16 + 4 * kq + i]); }
            w.x = cvtpk(v[0], v[1]); w.y = cvtpk(v[2], v[3]); w.z = cvtpk(v[4], v[5]); w.w = cvtpk(v[6], v[7]); hf[s] = __builtin_bit_cast(bf16x8, w); }
        f32x4 o2[4] = {};
#pragma unroll
        for (int et = 0; et < 4; ++et)
#pragma unroll
            for (int s = 0; s < 2; ++s) { const bf16* w2r = W2 + (size_t)(16 * et + (lane & 15)) * 64 + 32 * s + 4 * kq;
                const u32x2 a = *(const u32x2*)w2r, bq = *(const u32x2*)(w2r + 16); u32x4 w; w.x = a.x; w.y = a.y; w.z = bq.x; w.w = bq.y;
                o2[et] = __builtin_amdgcn_mfma_f32_16x16x32_bf16(__builtin_bit_cast(bf16x8, w), hf[s], o2[et], 0, 0, 0); }
#pragma unroll
        for (int et = 0; et < 4; ++et) { u32x2 w; w.x = cvtpk(o2[et][0], o2[et][1]); w.y = cvtpk(o2[et][2], o2[et][3]); if (c == 127) { w.x = 0u; w.y = 0u; }
            *(u32x2*)(O + (size_t)c * 64 + 16 * et + 4 * kq) = w; }
    }
}
constexpr int GM_ROWB = 1024 + 16;
__device__ __forceinline__ void gmlp_item(const Ptrs& P, LAS unsigned char* lds, int layer, int b, int ch, int tid, int lane, int wid) {
    bf16* U = (bf16*)slot_ptr(P.ws, P.out, SL_U); const bf16* V = (const bf16*)slot_ptr(P.ws, P.out, SL_V); const bf16* AZ = (const bf16*)slot_ptr(P.ws, P.out, SL_AZ);
    const bf16* WSP = (const bf16*)(wbase(P.ws, P.out, layer) + W_WS); const float* lng = P.in[7] + layer * 512; const float* lnb = P.in[8] + layer * 512; const float* bs = P.in[10] + layer * 512;
    const size_t r0 = (size_t)b * SEQ + 128 * ch;
    {
        float gam[8], bet[8];
#pragma unroll
        for (int i = 0; i < 8; ++i) { gam[i] = lng[8 * lane + i]; bet[i] = lnb[8 * lane + i]; }
        u32x4 raws[16];
#pragma unroll
        for (int rr = 0; rr < 16; ++rr) raws[rr] = *(const u32x4*)(V + (r0 + 16 * wid + rr) * 512 + 8 * lane);
        float s1[16], s2[16];
#pragma unroll
        for (int rr = 0; rr < 16; ++rr) { const u32x4 raw = raws[rr]; const float x[8] = {bflo(raw.x), bfhi(raw.x), bflo(raw.y), bfhi(raw.y), bflo(raw.z), bfhi(raw.z), bflo(raw.w), bfhi(raw.w)};
            float a = 0.f, q = 0.f;
#pragma unroll
            for (int i = 0; i < 8; ++i) { a += x[i]; q += x[i] * x[i]; }
            s1[rr] = a; s2[rr] = q; }
#pragma unroll
        for (int o = 1; o < 64; o <<= 1) {
#pragma unroll
            for (int rr = 0; rr < 16; ++rr) { s1[rr] += __shfl_xor(s1[rr], o); s2[rr] += __shfl_xor(s2[rr], o); }
        }
#pragma unroll
        for (int rr = 0; rr < 16; ++rr) { const int row = 16 * wid + rr; const u32x4 raw = raws[rr];
            const float x[8] = {bflo(raw.x), bfhi(raw.x), bflo(raw.y), bfhi(raw.y), bflo(raw.z), bfhi(raw.z), bflo(raw.w), bfhi(raw.w)};
            const float mu = s1[rr] * (1.f / 512.f); const float var = fmaxf(s2[rr] * (1.f / 512.f) - mu * mu, 0.f); const float rstd = 1.f / sqrtf(var + EPS);
            float y[8];
#pragma unroll
            for (int i = 0; i < 8; ++i) y[i] = (x[i] - mu) * rstd * gam[i] + bet[i];
            u32x4 w; w.x = cvtpk(y[0], y[1]); w.y = cvtpk(y[2], y[3]); w.z = cvtpk(y[4], y[5]); w.w = cvtpk(y[6], y[7]);
            *(LAS u32x4*)(lds + row * GM_ROWB + 16 * lane) = w; }
    }
    __syncthreads();
    const int tl = lane & 15, kq = lane >> 4, t = 16 * wid + tl; const int nks = (16 * wid + 15) / 32 + 1;
    const LAS unsigned char* vb = lds + (8 * kq + ((lane >> 2) & 3)) * GM_ROWB + 8 * (lane & 3);
    for (int g = 0; g < 4; ++g) {
        f32x4 acc[8] = {};
        const bf16* wrow = WSP + (size_t)(g * 128 + t) * 128 + 8 * kq;
        bf16x8 wfs[4];
#pragma unroll
        for (int ks = 0; ks < 4; ++ks) wfs[ks] = *(const bf16x8*)(wrow + 32 * (ks < nks ? ks : 0));
        u32x2 uus[8], zzs[8];
#pragma unroll
        for (int dt = 0; dt < 8; ++dt) { const size_t off = (r0 + t) * 512 + g * 128 + 16 * dt + 4 * kq; uus[dt] = *(const u32x2*)(U + off); zzs[dt] = *(const u32x2*)(AZ + off); }
        const float bsv = bs[g * 128 + t];
#pragma unroll
        for (int ks = 0; ks < 4; ++ks) {
            if (ks < nks) {
                const bf16x8 wf = wfs[ks];
#pragma unroll
                for (int dt = 0; dt < 8; ++dt) { const LAS unsigned char* p = vb + (32 * ks) * GM_ROWB + (g * 128 + 16 * dt) * 2;
                    const s16x4 lo = vtr(p), hh = vtr(p + 4 * GM_ROWB); const bf16x8 vf = (bf16x8){lo[0], lo[1], lo[2], lo[3], hh[0], hh[1], hh[2], hh[3]};
                    acc[dt] = __builtin_amdgcn_mfma_f32_16x16x32_bf16(vf, wf, acc[dt], 0, 0, 0); }
            }
        }
#pragma unroll
        for (int dt = 0; dt < 8; ++dt) { const size_t off = (r0 + t) * 512 + g * 128 + 16 * dt + 4 * kq; const u32x2 uu = uus[dt], zz = zzs[dt];
            u32x2 w; w.x = cvtpk((acc[dt][0] + bsv) * gelu_f(bflo(uu.x)) * silu_f(bflo(zz.x)), (acc[dt][1] + bsv) * gelu_f(bfhi(uu.x)) * silu_f(bfhi(zz.x))); w.y = cvtpk((acc[dt][2] + bsv) * gelu_f(bflo(uu.y)) * silu_f(bflo(zz.y)), (acc[dt][3] + bsv) * gelu_f(bfhi(uu.y)) * silu_f(bfhi(zz.y)));
            *(u32x2*)(U + off) = w; }
    }
    __syncthreads();
}
__device__ __forceinline__ void cumsum_item(const Ptrs& P, LAS unsigned char* lds, int b, int h, int tid, int lane, int wid) {
    const float* SM = (const float*)(P.ws + WS_SM) + ((size_t)b * SEQ + 4 * tid) * 32 + 24 + h;
    bf16* KX = (bf16*)(P.ws + WS_KX) + ((size_t)(b * 8 + h) * SEQ + 4 * tid) * 16; bf16* QX = (bf16*)(P.ws + WS_QX) + ((size_t)(b * 8 + h) * SEQ + 4 * tid) * 8;
    LAS float* wsum = (LAS float*)(lds + LDS_MISC + 64);
    float v[4];
#pragma unroll
    for (int i = 0; i < 4; ++i) v[i] = SM[(size_t)i * 32];
    v[1] += v[0]; v[2] += v[1]; v[3] += v[2];
    float tot = v[3];
#pragma unroll
    for (int o = 1; o < 64; o <<= 1) { const float x = __shfl_up(tot, o); if (lane >= o) tot += x; }
    if (lane == 63) wsum[wid] = tot;
    __syncthreads();
    float base = tot - v[3];
    for (int w = 0; w < wid; ++w) base += wsum[w];
#pragma unroll
    for (int i = 0; i < 4; ++i) { const float c = v[i] + base;
        const unsigned h0 = cvtpk(c, 0.f) & 0xffffu; const float r1 = c - __uint_as_float(h0 << 16);
        const unsigned h1 = cvtpk(r1, 0.f) & 0xffffu; const float r2 = r1 - __uint_as_float(h1 << 16);
        const unsigned h2 = cvtpk(r2, 0.f) & 0xffffu;
        const unsigned ONE = 0x3f80u;
        u32x4 q; q.x = ONE | (ONE << 16); q.y = ONE | (h0 << 16); q.z = h1 | (h2 << 16); q.w = 0u;
        *(u32x4*)(QX + i * 8) = q;
        u32x4 k; k.x = (h0 ^ 0x8000u) | ((h1 ^ 0x8000u) << 16); k.y = (h2 ^ 0x8000u) | (ONE << 16); k.z = ONE | (ONE << 16); k.w = 0u;
        *(u32x4*)(KX + i * 16) = k; *(u32x4*)(KX + i * 16 + 8) = (u32x4){0u, 0u, 0u, 0u}; }
}


__device__ __forceinline__ void prep_item(const float* W, int K, int Nsrc, const float* scale, bf16* out, int row_off, int P, bool projmap, LAS float* scr, int item, int lane) {
    const int nblk = P / 32, kb = item / nblk, nb = item % nblk, k0 = 64 * kb, n0 = 32 * nb;
    const int p = n0 + (lane & 31); const int src = projmap ? proj_src(p) : p;
    float wv[32];
#pragma unroll
    for (int i = 0; i < 32; ++i) { const int kk = 2 * i + (lane >> 5); wv[i] = src >= 0 ? W[(size_t)(k0 + kk) * Nsrc + src] : 0.f; }
    if (scale) {
#pragma unroll
        for (int i = 0; i < 32; ++i) wv[i] *= scale[k0 + 2 * i + (lane >> 5)];
    }
#pragma unroll
    for (int i = 0; i < 32; ++i) scr[(2 * i + (lane >> 5)) * 33 + (lane & 31)] = wv[i];
    asm volatile("s_waitcnt lgkmcnt(0)" ::: "memory");
    const int c = lane & 7;
#pragma unroll
    for (int j = 0; j < 4; ++j) { const int n = (lane >> 3) + 8 * j; const LAS float* s = scr + (8 * c) * 33 + n;
        u32x4 o; o.x = cvtpk(s[0 * 33], s[1 * 33]); o.y = cvtpk(s[2 * 33], s[3 * 33]); o.z = cvtpk(s[4 * 33], s[5 * 33]); o.w = cvtpk(s[6 * 33], s[7 * 33]);
        *(u32x4*)(out + (size_t)(row_off + n0 + n) * K + k0 + 8 * c) = o; }
    asm volatile("s_waitcnt lgkmcnt(0)" ::: "memory");
}
constexpr int PREP_EARLY = 480, PREP_LATE = 448, PREP_SMALL = 64, PREP_UNITS = PREP_EARLY + PREP_LATE + PREP_SMALL;
__device__ __forceinline__ void prep_unit(const Ptrs& P, LAS unsigned char* lds, int layer, int u, int tid, int lane, int wid) {
    unsigned char* W = wbase(P.ws, P.out, layer);
    if (u < PREP_EARLY + PREP_LATE) {
        LAS float* scr = (LAS float*)(lds + wid * 8704);
        const float* w_in = P.in[2] + (size_t)layer * DM * D_IN; const float* g_pre = P.in[3] + layer * DM; const float* g_mem = P.in[5] + layer * DM;
        const float* w_mem = P.in[6] + (size_t)layer * DM * 1024; const float* w_br = P.in[18] + (size_t)layer * 4 * 512 * 1024; const float* w_gate = P.in[19] + (size_t)layer * DM * 4096; const float* w_o = P.in[20] + (size_t)layer * DM * DM;
        constexpr int I1 = 16 * (NP1 / 32), I2 = 16 * (NGATE / 32), I3 = 8 * 32, I4 = 16 * 32, I5 = 16 * 32;
        static_assert(I1 + I5 == 8 * PREP_EARLY && I2 + 4 * I3 + I4 == 8 * PREP_LATE, "prep unit counts");
        if (u < PREP_EARLY) { int r = 8 * u + wid;
            if (r < I1) prep_item(w_in, DM, D_IN, g_pre, (bf16*)(W + W_IN), 0, NP1, true, scr, r, lane);
            else prep_item(w_mem, DM, 1024, g_mem, (bf16*)(W + W_M), 0, 1024, false, scr, r - I1, lane);
        } else { int r = 8 * (u - PREP_EARLY) + wid;
            if (r < I2) prep_item(w_gate, DM, NGATE, g_pre, (bf16*)(W + W_IN), NP1, NGATE, false, scr, r, lane);
            else if (r < I2 + 4 * I3) { r -= I2; const int n = r / I3; prep_item(w_br + (size_t)n * 512 * 1024, 512, 1024, nullptr, (bf16*)(W + W_BR) + (size_t)n * 1024 * 512, 0, 1024, false, scr, r % I3, lane); }
            else prep_item(w_o, DM, DM, nullptr, (bf16*)(W + W_O), 0, 1024, false, scr, r - I2 - 4 * I3, lane);
        }
    } else {
        const int c = u - PREP_EARLY - PREP_LATE;
        const float* w1k = P.in[12] + (size_t)layer * 2048 * 64; const float* w2k = P.in[13] + layer * 4096; const float* w1v = P.in[15] + (size_t)layer * 2048 * 64; const float* w2v = P.in[16] + layer * 4096;
        const float* a_ws = P.in[9] + (size_t)layer * 4 * 128 * 128;
        bf16* W1K = (bf16*)(W + W_1K); bf16* W1V = (bf16*)(W + W_1V); bf16* W2K = (bf16*)(W + W_2K); bf16* W2V = (bf16*)(W + W_2V); bf16* WSP = (bf16*)(W + W_WS);
#pragma unroll
        for (int q = 0; q < 4; ++q) { const int i = c * 2048 + q * 512 + tid; const int e = i >> 11, kk = i & 2047, l = kk >> 6, pp = kk & 63;
            W1K[i] = (bf16)(cvtpk(w1k[(size_t)(l * 64 + dperm(pp)) * 64 + e], 0.f) & 0xffffu); W1V[i] = (bf16)(cvtpk(w1v[(size_t)kk * 64 + e], 0.f) & 0xffffu); }
        if (tid < 64) { const int i = c * 64 + tid; const int e2 = i >> 6, h = i & 63; W2K[i] = (bf16)(cvtpk(w2k[h * 64 + dperm(e2)], 0.f) & 0xffffu); W2V[i] = (bf16)(cvtpk(w2v[h * 64 + e2], 0.f) & 0xffffu); }
#pragma unroll
        for (int q = 0; q < 2; ++q) { const int i = c * 1024 + q * 512 + tid; const int t = (i >> 7) & 127, s = i & 127; WSP[i] = (bf16)(cvtpk(s <= t ? a_ws[i] : 0.f, 0.f) & 0xffffu); }
        if (wid < 2) { const int o = 2 * c + wid; const int which = o >> 6, e = o & 63; const float* pos = (which ? P.in[14] : P.in[11]) + layer * 2048; const float* w1 = which ? w1v : w1k; float s = 0.f;
#pragma unroll
            for (int ii = 0; ii < 32; ++ii) { const int i = lane + 64 * ii; s += pos[i] * w1[(size_t)i * 64 + e]; }
            s = wave_sum(s); if (lane == 0) ((float*)(P.ws + WS_BIAS1))[o] = s; }
    }
}
__device__ __forceinline__ void prologue(const Ptrs& P, LAS unsigned char* lds, int gw, int ngw, int gtid, int ngt, int lane, int wid) {
    for (int u = blockIdx.x; u < PREP_EARLY + PREP_SMALL; u += gridDim.x) prep_unit(P, lds, 0, u < PREP_EARLY ? u : u + PREP_LATE, wid * 64 + lane, lane, wid);
    float* rc = (float*)(P.ws + WS_ROPEC); float* rs = (float*)(P.ws + WS_ROPES);
    for (int idx = gtid; idx < SEQ * 32; idx += ngt) { const int pos = idx >> 5, i = idx & 31;
        double f = 1.0; for (int k = 0; k < i; ++k) f *= 0.7498942093324559;
        const double x2 = f * f; double cs = 1.0, sn = f, tc = 1.0, ts = f;
        for (int k = 1; k <= 12; ++k) { tc *= -x2 / (double)((2 * k - 1) * (2 * k)); ts *= -x2 / (double)((2 * k) * (2 * k + 1)); cs += tc; sn += ts; }
        double rcv = 1.0, rsv = 0.0, bc = cs, bs = sn;
        for (int bit = 0; bit < 11; ++bit) { if ((pos >> bit) & 1) { const double a = rcv * bc - rsv * bs, b2 = rcv * bs + rsv * bc; rcv = a; rsv = b2; } const double nc = bc * bc - bs * bs, ns = 2.0 * bc * bs; bc = nc; bs = ns; }
        rc[idx] = (float)rcv; rs[idx] = (float)rsv; }
    const float* x = P.in[0]; const float* mem = P.in[1]; bf16* XB = (bf16*)(P.ws + WS_XB); bf16* MEMB = (bf16*)(P.ws + WS_MEMB); float* rinv = (float*)(P.ws + WS_RINV); float* rinvm = (float*)(P.ws + WS_RINVM);
    constexpr int NR = 4;
    for (int r0 = gw; r0 < NT + NMEM; r0 += NR * ngw) {
        f32x4 v[NR][4];
#pragma unroll
        for (int q = 0; q < NR; ++q) { const int r = r0 + q * ngw; if (r < NT + NMEM) { const bool ism = r >= NT; const int row = ism ? r - NT : r; const float* src = (ism ? mem : x) + (size_t)row * DM;
#pragma unroll
            for (int j = 0; j < 4; ++j) v[q][j] = *(const f32x4*)(src + 4 * lane + 256 * j); } }
#pragma unroll
        for (int q = 0; q < NR; ++q) { const int r = r0 + q * ngw; if (r < NT + NMEM) { const bool ism = r >= NT; const int row = ism ? r - NT : r; bf16* dst = (ism ? MEMB : XB) + (size_t)row * DM; float ss = 0.f;
#pragma unroll
            for (int j = 0; j < 4; ++j) { const f32x4 w4 = v[q][j]; ss += (w4[0] * w4[0] + w4[1] * w4[1]) + (w4[2] * w4[2] + w4[3] * w4[3]); u32x2 w; w.x = cvtpk(w4[0], w4[1]); w.y = cvtpk(w4[2], w4[3]); *(u32x2*)(dst + 4 * lane + 256 * j) = w; }
            ss = wave_sum(ss); if (lane == 0) (ism ? rinvm : rinv)[row] = 1.f / sqrtf(ss * (1.f / DM) + EPS); } }
    }
}
__device__ __forceinline__ void finish_layer(const Ptrs& P, int layer, int gw, int ngw, int lane) {
    float* OUT = (float*)P.out; const bf16* OUTB = (const bf16*)gate_ptr(P.ws, P.out, 0); const float* part = (const float*)(P.ws + WS_PART); const float* gp = P.in[4] + layer * DM; const float* x = P.in[0];
    bf16* XB = (bf16*)(P.ws + WS_XB); float* rinv = (float*)(P.ws + WS_RINV);
    f32x4 g4[4];
#pragma unroll
    for (int j = 0; j < 4; ++j) g4[j] = *(const f32x4*)(gp + 4 * lane + 256 * j);
    constexpr int NR = 4;
    for (int row0 = gw; row0 < NT; row0 += NR * ngw) {
        f32x4 o4[NR][4], xv[NR][4]; float sp[NR];
#pragma unroll
        for (int q = 0; q < NR; ++q) { const int row = row0 + q * ngw; if (row < NT) { sp[q] = part[(size_t)row * 16 + (lane & 15)];
#pragma unroll
            for (int j = 0; j < 4; ++j) { const size_t off = (size_t)row * DM + 4 * lane + 256 * j; { const u32x2 w = *(const u32x2*)(OUTB + off); o4[q][j] = (f32x4){bflo(w.x), bfhi(w.x), bflo(w.y), bfhi(w.y)}; }
                { const u32x2 w = *(const u32x2*)(XB + off); xv[q][j] = (f32x4){bflo(w.x), bfhi(w.x), bflo(w.y), bfhi(w.y)}; } } } }
#pragma unroll
        for (int q = 0; q < NR; ++q) { const int row = row0 + q * ngw; if (row < NT) {
            float s = sp[q]; s += __shfl_xor(s, 1); s += __shfl_xor(s, 2); s += __shfl_xor(s, 4); s += __shfl_xor(s, 8);
            const float rs = 1.f / sqrtf(s * (1.f / DM) + EPS); float ss = 0.f;
#pragma unroll
            for (int j = 0; j < 4; ++j) { const size_t off = (size_t)row * DM + 4 * lane + 256 * j; const f32x4 xn = xv[q][j] + o4[q][j] * rs * g4[j];
                if (layer == 0) { ss += (xn[0] * xn[0] + xn[1] * xn[1]) + (xn[2] * xn[2] + xn[3] * xn[3]); u32x2 w; w.x = cvtpk(xn[0], xn[1]); w.y = cvtpk(xn[2], xn[3]); *(u32x2*)(XB + off) = w; }
                else *(f32x4*)(OUT + off) = xn; }
            if (layer == 0) { ss = wave_sum(ss); if (lane == 0) rinv[row] = 1.f / sqrtf(ss * (1.f / DM) + EPS); } } }
    }
}

struct Args { Ptrs p; int nph; unsigned char prog[28]; };
constexpr int NPHASE = 13;
struct GateOrder {
    pg8::StaticOrder base;
    __device__ void init(int G, int c) { base.init(NT, DM, G, c); }
    __device__ bool next(int i, pg8::Unit& u) const { if (!base.next(i >> 2, u)) return false; u.pn += 4 * (i & 3); return true; }
    __device__ __forceinline__ void a_ready(const pg8::Unit&) const {}
    __device__ __forceinline__ void done(const pg8::Unit&) const {}
};
__device__ __forceinline__ int dequeue(unsigned* ctr, LAS int* slot, int tid) {
    __syncthreads();
    if (tid == 0) *slot = (int)atomicAdd(ctr, 1u);
    __syncthreads();
    return *slot;
}
#define QUEUE_LOOP(ctr, qslot, tid0, LIMIT, ...) do { \
        for (;;) { const int idx = dequeue(ctr, qslot, tid0); if (idx >= (LIMIT)) break; \
            { __VA_ARGS__ } } } while (0)

template <int KIND> __device__ __forceinline__ void run_phase(const Ptrs& P, LAS unsigned char* lds, int ph, int qi, int tid, int lane_in, int wid) {
    const int lane = lane_in;
    int G = gridDim.x, bid = blockIdx.x; asm volatile("" : "+s"(G), "+s"(bid));
    const int gw = bid * 8 + wid, ngw = G * 8, gtid = bid * 512 + tid, ngt = G * 512;
    unsigned* ctl = (unsigned*)(P.ws + WS_CTL); LAS int* qslot = (LAS int*)(lds + LDS_MISC);
    if (ph == 0) { if (KIND < 0 || KIND == 0) prologue(P, lds, gw, ngw, gtid, ngt, lane, wid); }
        else if (ph < NPHASE) {
            const int layer = (ph - 1) / 6, sub = (ph - 1) % 6; unsigned char* W = wbase(P.ws, P.out, layer);
            if (sub == 0 && (KIND < 0 || KIND == 1)) {
                { pg8::Gemm g{(const bf16*)(P.ws + WS_XB), (const bf16*)(W + W_IN), NT, NP1, DM}; pg8::StaticOrder S; S.init(NT, NP1, G, bid);
                  pg8::EpiG1 E{P.ws, P.out, (const float*)(P.ws + WS_RINV), P.in[17] + layer * 8, (const float*)(P.ws + WS_ROPEC), (const float*)(P.ws + WS_ROPES), (float*)(P.ws + WS_SM)};
                  pg8::gemm_phase<pg8::EpiG1, pg8::StaticOrder, true, true>(lds, g, S, E, tid); }
                { int tid2 = tid; asm volatile("" : "+v"(tid2)); const int tid = tid2;
                  pg8::Gemm g{(const bf16*)(P.ws + WS_MEMB), (const bf16*)(W + W_M), NMEM, 1024, DM}; pg8::StaticOrder S; S.init(NMEM, 1024, G, (bid + G / 2) % G);
                  pg8::EpiRowScale E{(bf16*)(P.ws + WS_MKV), 1024, (const float*)(P.ws + WS_RINVM)};
                  pg8::gemm_phase<pg8::EpiRowScale, pg8::StaticOrder, true, true>(lds, g, S, E, tid); }
            } else if (sub == 1 && (KIND < 0 || KIND == 2)) {
                unsigned* ctr = ctl + CW_Q + 16 * qi;
                QUEUE_LOOP(ctr, qslot, tid, 576, {
                    int lane = lane_in; asm volatile("" : "+v"(lane)); const int tid = wid * 64 + lane;
                    if (idx < 128) cmp_item(P, lds, layer, (idx >> 2) & 7, (idx >> 1) & 1, idx & 1, idx >> 5, lane, wid);
                    else if (idx < 192) { const int i = idx - 128; cumsum_item(P, lds, i >> 3, i & 7, tid, lane, wid); }
                    else if (idx < 320) { const int i = idx - 192; gmlp_item(P, lds, layer, i >> 4, i & 15, tid, lane, wid); }
                    else { const int i = idx - 320; mem_item(P, lds, i >> 5, (i >> 3) & 3, i & 7, tid, lane, wid); } });
            } else if (sub == 2 && (KIND < 0 || KIND == 3)) {
                unsigned* ctr = ctl + CW_Q + 16 * qi;
                QUEUE_LOOP(ctr, qslot, tid, (layer == 0 ? 1024 + PREP_LATE + PREP_UNITS : 1024), {
                    int lane = lane_in; asm volatile("" : "+v"(lane)); const int tid = wid * 64 + lane;
                    if (idx >= 1024) { const int f = idx - 1024; if (f < PREP_LATE) prep_unit(P, lds, 0, PREP_EARLY + f, tid, lane, wid); else prep_unit(P, lds, 1, f - PREP_LATE, tid, lane, wid); continue; }
                    int isn, i, q;
                    if (idx < 256) { isn = 1; i = idx; q = 31 - (i >> 4); }
                    else if (idx < 512) { isn = 0; i = idx - 256; q = 7 - (i >> 6); }
                    else if (idx < 640) { isn = 1; i = idx - 512; q = 15 - (i >> 4); }
                    else if (idx < 768) { isn = 0; i = idx - 640; q = 3 - (i >> 6); }
                    else if (idx < 896) { isn = 1; i = idx - 768; q = 7 - (i >> 4); }
                    else { isn = 0; i = idx - 896; q = 1 - (i >> 6); }
                    if (isn) nsa_item(P, lds, (i & 15) >> 1, i & 1, q, tid, lane, wid);
                    else fa_item(P, lds, (i & 63) >> 3, i & 7, q, tid, lane, wid); });
            } else if (sub == 3 && (KIND < 0 || KIND == 4)) {
                unsigned char* g0 = gate_ptr(P.ws, P.out, 0); unsigned char* g1 = gate_ptr(P.ws, P.out, 1); unsigned char* g2 = gate_ptr(P.ws, P.out, 2); unsigned char* g3 = gate_ptr(P.ws, P.out, 3);
                { pg8::Gemm g{(const bf16*)(P.ws + WS_XB), (const bf16*)(W + W_IN) + (size_t)NP1 * DM, NT, NGATE, DM}; GateOrder S; S.init(G, bid);
                  pg8::EpiGate E{g0, g1, g2, g3, (const float*)(P.ws + WS_RINV)};
                  pg8::gemm_phase<pg8::EpiGate, GateOrder, true, true>(lds, g, S, E, tid); }
                { int tid2 = tid; asm volatile("" : "+v"(tid2)); const int tid = tid2;
                  pg8::Gemm g{(const bf16*)slot_ptr(P.ws, P.out, 0), (const bf16*)(W + W_BR), 4 * NT, 4096, 512}; pg8::MergeOrder S; S.init(G, bid);
                  pg8::EpiMerge E{g0, g1, g2, g3, (bf16*)(P.ws + WS_MERGED)};
                  pg8::gemm_phase<pg8::EpiMerge, pg8::MergeOrder, true, true>(lds, g, S, E, tid); }
            } else if (sub == 4 && (KIND < 0 || KIND == 5)) {
                pg8::Gemm g{(const bf16*)(P.ws + WS_MERGED), (const bf16*)(W + W_O), NT, DM, DM}; pg8::StaticOrder S; S.init(NT, DM, G, bid);
                pg8::EpiOut E{(bf16*)gate_ptr(P.ws, P.out, 0), (float*)(P.ws + WS_PART)};
                pg8::gemm_phase<pg8::EpiOut, pg8::StaticOrder, true, true>(lds, g, S, E, tid);
            } else if (sub == 5 && (KIND < 0 || KIND == 6)) {
                finish_layer(P, layer, gw, ngw, lane);
            }
        }
}
#define XB_TMO      128
#define XB_XCNT(j)  (256  + 64 * (j))
#define XB_XSUB(j)  (1280 + 64 * (j))
#define XB_XGEN(j)  (2304 + 64 * (j))
#define XB_TOP      3328
#define XB_TOPGEN   3392
#define XCD_BAR_WORDS 3456
#define XB_SPIN_CAP (1u << 18)

__device__ __forceinline__ unsigned xb_ld(unsigned* p)              { return __hip_atomic_load(p, __ATOMIC_RELAXED, __HIP_MEMORY_SCOPE_AGENT); }
__device__ __forceinline__ unsigned xb_add(unsigned* p, unsigned v) { return __hip_atomic_fetch_add(p, v, __ATOMIC_RELAXED, __HIP_MEMORY_SCOPE_AGENT); }
__device__ __forceinline__ unsigned xb_xcc_id() { return (unsigned)__builtin_amdgcn_s_getreg((3 << 11) | 20) & 0xFu; }
#define XB_SPIN(cond, bar) do { unsigned _sp = 0; while (cond) { __builtin_amdgcn_s_sleep(1); \
    if ((++_sp & 255u) == 0u) { if (xb_ld(&(bar)[XB_TMO])) break; if (_sp > XB_SPIN_CAP) { atomicAdd(&(bar)[XB_TMO], 1u); break; } } } } while (0)

struct XcdBarrier {
    unsigned* bar; unsigned x;
    volatile LAS unsigned* st;
};

__device__ __forceinline__ XcdBarrier xcd_barrier_post(unsigned* bar, volatile LAS unsigned* st) {
    XcdBarrier b; b.bar = bar; b.x = xb_xcc_id(); b.st = st;
    if (threadIdx.x == 0) (void)xb_add(&bar[XB_XCNT(b.x)], 1u);
    return b;
}
__device__ __forceinline__ void xcd_barrier_complete(unsigned* bar, unsigned x, unsigned& nloc, unsigned& nx) {
    const unsigned G = gridDim.x * gridDim.y * gridDim.z;
    unsigned sum, cnt, mine, sp = 0u;
    for (;;) {
        sum = 0u; cnt = 0u; mine = 0u;
#pragma unroll
        for (unsigned j = 0; j < 16; ++j) { const unsigned c = xb_ld(&bar[XB_XCNT(j)]); sum += c; cnt += (c > 0u) ? 1u : 0u; mine = (j == x) ? c : mine; }
        if (sum == G) break;
        __builtin_amdgcn_s_sleep(1);
        if ((++sp & 255u) == 0u) { if (xb_ld(&bar[XB_TMO])) break; if (sp > XB_SPIN_CAP) { atomicAdd(&bar[XB_TMO], 1u); break; } }
    }
    nloc = mine > 0u ? mine : 1u; nx = cnt > 0u ? cnt : 1u;
}

__device__ __forceinline__ void xcd_barrier(const XcdBarrier& b) {
    asm volatile("s_waitcnt vmcnt(0)" ::: "memory");
    __syncthreads();
    if (threadIdx.x == 0) {
        unsigned* bar = b.bar;
        __builtin_amdgcn_s_waitcnt(0);
        unsigned nloc = b.st[0], nx = b.st[1];
        if (nloc == 0u) { xcd_barrier_complete(bar, b.x, nloc, nx); b.st[0] = nloc; b.st[1] = nx; }
        const unsigned old = xb_add(&bar[XB_XSUB(b.x)], 1u);
        const unsigned gen = old / nloc;
        if (old + 1u == (gen + 1u) * nloc) {
            __builtin_amdgcn_fence(__ATOMIC_RELEASE, "agent");
            asm volatile("s_waitcnt vmcnt(0)" ::: "memory");
            const unsigned og = xb_add(&bar[XB_TOP], 1u);
            const unsigned tg = og / nx;
            if (og + 1u == (tg + 1u) * nx) xb_add(&bar[XB_TOPGEN], 1u);
            else XB_SPIN(xb_ld(&bar[XB_TOPGEN]) == tg, bar);
            __builtin_amdgcn_fence(__ATOMIC_ACQUIRE, "agent");
            xb_add(&bar[XB_XGEN(b.x)], 1u);
            asm volatile("s_waitcnt vmcnt(0)" ::: "memory");
        } else {
            XB_SPIN(xb_ld(&bar[XB_XGEN(b.x)]) == gen, bar);
            __builtin_amdgcn_fence(__ATOMIC_ACQUIRE, "agent");
            asm volatile("s_waitcnt vmcnt(0)" ::: "memory");
        }
    }
    __syncthreads();
}

constexpr int CW_BAR = 4096;
typedef const __attribute__((address_space(4))) Args* KArgP;
__global__ void __launch_bounds__(512, 2) hybrid_fwd(Args a_unused) {
    extern __shared__ __attribute__((aligned(16))) unsigned char lds_raw[];
    KArgP kp = (KArgP)__builtin_amdgcn_kernarg_segment_ptr();
    const int nph = kp->nph;
    const int wid0 = __builtin_amdgcn_readfirstlane((int)threadIdx.x >> 6);
    {
        volatile LAS unsigned* st = (volatile LAS unsigned*)((LAS unsigned char*)lds_raw + LDS_MISC + 16);
        if (threadIdx.x < 2) st[threadIdx.x] = 0u;
        __syncthreads();
        (void)xcd_barrier_post((unsigned*)(kp->p.ws + WS_CTL) + CW_BAR, st);
    }
    for (int pi = 0; pi < nph; ++pi) {
        int wid = wid0; asm volatile("" : "+s"(wid));
        int lane; asm volatile("v_mbcnt_lo_u32_b32 %0, -1, 0\n\tv_mbcnt_hi_u32_b32 %0, -1, %0" : "=v"(lane));
        const int tid = wid * 64 + lane;
        KArgP kq = kp; asm volatile("" : "+s"(kq));
        LAS unsigned char* lds = (LAS unsigned char*)lds_raw;
        Ptrs P;
#pragma unroll
        for (int i = 0; i < 21; ++i) P.in[i] = kq->p.in[i];
        P.out = kq->p.out; P.ws = kq->p.ws;
        const int ph = kq->prog[pi];
        run_phase<-1>(P, lds, ph, pi, tid, lane, wid);
        if (pi + 1 < nph) {
            if (nph > 64) cg::this_grid().sync();
            else { XcdBarrier b; b.bar = (unsigned*)(P.ws + WS_CTL) + CW_BAR; b.x = xb_xcc_id(); b.st = (volatile LAS unsigned*)(lds + LDS_MISC + 16); xcd_barrier(b); }
        }
    }
}
#ifdef DIAG_KERNELS
template <int KIND> __global__ void __launch_bounds__(512, 2) phase_k(Args a) {
    extern __shared__ __attribute__((aligned(16))) unsigned char lds_raw[];
    LAS unsigned char* lds = (LAS unsigned char*)lds_raw;
    const int tid = threadIdx.x, lane = tid & 63, wid = __builtin_amdgcn_readfirstlane(tid >> 6);
    run_phase<KIND>(a.p, lds, a.prog[0], 0, tid, lane, wid);
}
template __global__ void phase_k<0>(Args);
template __global__ void phase_k<1>(Args);
template __global__ void phase_k<2>(Args);
template __global__ void phase_k<3>(Args);
template __global__ void phase_k<4>(Args);
template __global__ void phase_k<5>(Args);
template __global__ void phase_k<6>(Args);

#endif
extern "C" void kernel_launch(void* const* d_in, const int* in_sizes, int n_in, void* d_out, int out_size, void* d_ws, size_t ws_size, hipStream_t stream) {
    static int grid = 0;
    if (grid == 0) {
        if (n_in != 21 || out_size != NT * DM || ws_size < WS_NEED) { fprintf(stderr, "kernel_launch: unexpected shapes (n_in %d out %d ws %zu)\n", n_in, out_size, ws_size); grid = -1; return; }
        int dev = 0, cus = 0, per_cu = 0;
        hipGetDevice(&dev); hipDeviceGetAttribute(&cus, hipDeviceAttributeMultiprocessorCount, dev);
        if (hipFuncSetAttribute((const void*)hybrid_fwd, hipFuncAttributeMaxDynamicSharedMemorySize, LDS_BYTES) != hipSuccess) { fprintf(stderr, "kernel_launch: hipFuncSetAttribute failed\n"); grid = -1; return; }
        hipOccupancyMaxActiveBlocksPerMultiprocessor(&per_cu, (const void*)hybrid_fwd, 512, LDS_BYTES);
        (void)hipGetLastError();
        if (per_cu < 1) { fprintf(stderr, "kernel_launch: occupancy query reports %d blocks per CU\n", per_cu); per_cu = 1; }
        grid = cus;
        if (grid % 8 != 0) grid -= grid % 8;
    }
    if (grid < 0) return;
    (void)hipMemsetAsync((char*)d_ws + WS_CTL, 0, 32768, stream);
    Args a{};
    for (int i = 0; i < 21; ++i) a.p.in[i] = (const float*)d_in[i];
    a.p.out = (unsigned char*)d_out; a.p.ws = (unsigned char*)d_ws;
    int n = 0;
#ifdef PROG_CUSTOM
    { const unsigned char pc[] = PROG_CUSTOM; for (unsigned i = 0; i < sizeof(pc); ++i) a.prog[n++] = pc[i]; }
#else
    for (int ph = 0; ph < NPHASE; ++ph) a.prog[n++] = (unsigned char)ph;
#endif
#if ONE_LAUNCH
    a.nph = n;
    void* args[] = {&a};
    hipError_t e = hipLaunchCooperativeKernel((const void*)hybrid_fwd, dim3(grid), dim3(512), args, LDS_BYTES, stream);
    if (e != hipSuccess) fprintf(stderr, "kernel_launch: cooperative launch failed: %s (grid %d)\n", hipGetErrorString(e), grid);
#else
    { Args b = a; b.nph = 1; for (int i = 0; i < n; ++i) { b.prog[0] = a.prog[i]; hipLaunchKernelGGL(hybrid_fwd, dim3(grid), dim3(512), LDS_BYTES, stream, b); } }
#endif
}
```

```cpp
#include <hip/hip_runtime.h>
#include <hip/hip_cooperative_groups.h>
#include <cstdio>
#include <cstdint>
#include <cmath>
namespace cg = cooperative_groups;
#ifndef ONE_LAUNCH
#define ONE_LAUNCH 1
#endif
namespace pg8 {
#define PG8_LAS __attribute__((address_space(3)))
typedef unsigned short bf16_t;
typedef short bf16x8 __attribute__((ext_vector_type(8)));
typedef float f32x4 __attribute__((ext_vector_type(4)));
typedef unsigned u32x4 __attribute__((ext_vector_type(4)));
constexpr int BM = 256, BK = 64, HALF = 128, HTB = HALF * BK * 2  , STAGE_BYTES = 8 * HTB, NXCD = 8, WGM = 8;

__host__ __device__ __forceinline__ int lds_byte(int r, int c) { const int st = (r >> 4) * 2 + (c >> 5), rr = r & 15, cc = c & 31, ob = rr * 64 + cc * 2; return st * 1024 + (ob ^ (((ob >> 9) & 1) << 5)); }
__host__ __device__ __forceinline__ void stage_rc(int b, int& R, int& C) { const int st = b / 1024, sb = b % 1024, swz = sb ^ (((sb >> 9) & 1) << 5); R = (st >> 1) * 16 + swz / 64; C = (st & 1) * 32 + (swz % 64) / 2; }
__host__ __device__ __forceinline__ int perm32(int rho) { const int n = rho >> 4, i = rho & 15; return 8 * (i >> 2) + 4 * n + (i & 3); }

struct Unit { int pm, pn; };
struct Gemm { const bf16_t* A; const bf16_t* Bt; int M, N, K; };

struct StaticOrder {
    int nM, nN, nwg, G, c;
    __host__ __device__ void init(int M, int N, int G_, int c_) { nM = M / BM; nN = N / BM; nwg = nM * nN; G = G_; c = c_; }
    __host__ __device__ bool next(int i, Unit& u) const {
        const long L = (long)i * G + c; if (L >= nwg) return false;
        int wgid = (int)L; { const int q = nwg / NXCD, r = nwg % NXCD, xcd = wgid % NXCD, off = wgid / NXCD; wgid = (xcd < r ? xcd * (q + 1) : r * (q + 1) + (xcd - r) * q) + off; }
        const int nig = WGM * nN, gid = wgid / nig, fm = gid * WGM, gsz = (nM - fm) < WGM ? (nM - fm) : WGM;
        u.pm = fm + ((wgid % nig) % gsz); u.pn = (wgid % nig) / gsz; return true;
    }
    __device__ __forceinline__ void a_ready(const Unit&) const {}
    __device__ __forceinline__ void done(const Unit&) const {}
};

template <class Epi, class Sched, bool ALIGN_EPI = false, bool SP2 = false>
__device__ __forceinline__ void gemm_phase(PG8_LAS unsigned char* lds, const Gemm g, const Sched& S, const Epi& E, const int tid) {
    const int wid = __builtin_amdgcn_readfirstlane(tid >> 6), lane = tid & 63, wr = wid >> 2, wc = wid & 3, fr = lane & 15, fq = lane >> 4;
    const int K = g.K, nt = K / BK;
    unsigned voffA[2], voffB[2];
#pragma unroll
    for (int i = 0; i < 2; ++i) { int R, C; stage_rc(tid * 16 + i * 8192, R, C); const int Rb = Epi::PERM ? ((R & ~31) + perm32(R & 31)) : R;
        voffA[i] = (unsigned)(R * K + C) * 2u; voffB[i] = (unsigned)(Rb * K + C) * 2u; }
    const size_t kstep = (size_t)(BK * 2);
    const size_t hstep = (size_t)HALF * K * 2;
    const size_t tstep = 2 * hstep;
    const unsigned ldsw = (unsigned)wid * 1024u;
    const int aoff = lds_byte(wr * 64 + fr, fq * 8), boff = lds_byte(wc * 32 + fr, fq * 8);
#define PG8_SA(b, h) (((b) * 2 + (h)) * HTB)
#define PG8_SB(b, h) ((4 + (b) * 2 + (h)) * HTB)
#define PG8_STAGE(bufoff, gbase, voff) do { _Pragma("unroll") for (int _i = 0; _i < 2; ++_i) \
        __builtin_amdgcn_global_load_lds((const unsigned*)((const char*)(gbase) + (voff)[_i]), (PG8_LAS unsigned*)(lds + (bufoff) + ldsw + _i * 8192), 16, 0, 0); } while (0)
#define PG8_LDA(dst, b, h) do { _Pragma("unroll") for (int m = 0; m < 4; ++m) _Pragma("unroll") for (int k = 0; k < 2; ++k) dst[m][k] = *(const PG8_LAS bf16x8*)(lds + PG8_SA(b, h) + aoff + m * 2048 + k * 1024); } while (0)
#define PG8_LDB(dst, b, h) do { _Pragma("unroll") for (int n = 0; n < 2; ++n) _Pragma("unroll") for (int k = 0; k < 2; ++k) dst[n][k] = *(const PG8_LAS bf16x8*)(lds + PG8_SB(b, h) + boff + n * 2048 + k * 1024); } while (0)
#define PG8_MMA(ai, bj, At, Bt) do { __builtin_amdgcn_s_setprio(1); _Pragma("unroll") for (int m = 0; m < 4; ++m) _Pragma("unroll") for (int n = 0; n < 2; ++n) _Pragma("unroll") for (int k = 0; k < 2; ++k) \
        acc[ai][bj][m][n] = __builtin_amdgcn_mfma_f32_16x16x32_bf16(Bt[n][k], At[m][k], acc[ai][bj][m][n], 0, 0, 0); __builtin_amdgcn_s_setprio(0); } while (0)
#define PG8_WAIT_V(n) asm volatile("s_waitcnt vmcnt(" #n ")" ::: "memory")
#define PG8_WAIT_L(n) asm volatile("s_waitcnt lgkmcnt(" #n ")" ::: "memory")
#define PG8_BAR __builtin_amdgcn_s_barrier()
#define PG8_SCHED __builtin_amdgcn_sched_barrier(0)
    Unit cur, nxt; int ui = 0;
    if (!S.next(0, cur)) return;
    f32x4 acc[2][2][4][2];
#pragma unroll
    for (int a = 0; a < 2; ++a)
#pragma unroll
        for (int b = 0; b < 2; ++b)
#pragma unroll
            for (int m = 0; m < 4; ++m)
#pragma unroll
                for (int n = 0; n < 2; ++n) acc[a][b][m][n] = (f32x4){0.f, 0.f, 0.f, 0.f};
    bf16x8 At[4][2], B0[2][2], B1[2][2];
    const char* cA = (const char*)g.A + (size_t)cur.pm * tstep; const char* cB = (const char*)g.Bt + (size_t)cur.pn * tstep;
    S.a_ready(cur);
    if constexpr (SP2) {
        PG8_STAGE(PG8_SB(0, 0), cB, voffB); PG8_STAGE(PG8_SB(0, 1), cB + hstep, voffB); PG8_STAGE(PG8_SA(0, 0), cA, voffA); PG8_STAGE(PG8_SA(0, 1), cA + hstep, voffA);
        if (wr == 1) PG8_BAR;
        PG8_WAIT_V(2); PG8_BAR;
        PG8_STAGE(PG8_SB(1, 0), cB + kstep, voffB); PG8_STAGE(PG8_SA(1, 0), cA + kstep, voffA); PG8_STAGE(PG8_SB(1, 1), cB + hstep + kstep, voffB);
        PG8_WAIT_V(6); PG8_BAR;
    } else {
        PG8_STAGE(PG8_SB(0, 0), cB, voffB); PG8_STAGE(PG8_SA(0, 0), cA, voffA); PG8_STAGE(PG8_SB(0, 1), cB + hstep, voffB); PG8_STAGE(PG8_SA(0, 1), cA + hstep, voffA);
        if (wr == 1) PG8_BAR;
        PG8_WAIT_V(4); PG8_BAR;
        PG8_STAGE(PG8_SB(1, 0), cB + kstep, voffB); PG8_STAGE(PG8_SA(1, 0), cA + kstep, voffA); PG8_STAGE(PG8_SB(1, 1), cB + hstep + kstep, voffB);
        PG8_WAIT_V(6); PG8_BAR;
    }
    for (;;) {
        const bool has_next = S.next(ui + 1, nxt);
        const char* nA = has_next ? (const char*)g.A + (size_t)nxt.pm * tstep : cA; const char* nB = has_next ? (const char*)g.Bt + (size_t)nxt.pn * tstep : cB;
        for (int t = 0; t < nt; t += 2) {
            const bool last = (t == nt - 2);
            const char* a1 = cA + (size_t)(t + 1) * kstep;
            const char* a2 = last ? nA : cA + (size_t)(t + 2) * kstep; const char* b2 = last ? nB : cB + (size_t)(t + 2) * kstep;
            const char* a3 = a2 + kstep; const char* b3 = b2 + kstep;
            if (last && has_next) S.a_ready(nxt);
            if constexpr (SP2) {
            PG8_LDB(B0, 0, 0); PG8_LDB(B1, 0, 1); PG8_SCHED; PG8_LDA(At, 0, 0); PG8_STAGE(PG8_SA(1, 1), a1 + hstep, voffA);
            PG8_WAIT_V(8); PG8_WAIT_L(0); PG8_BAR; PG8_MMA(0, 0, At, B0); PG8_MMA(0, 1, At, B1); PG8_BAR; PG8_SCHED;
            PG8_LDA(At, 0, 1); PG8_STAGE(PG8_SB(0, 0), b2, voffB); PG8_STAGE(PG8_SB(0, 1), b2 + hstep, voffB); PG8_STAGE(PG8_SA(0, 0), a2, voffA);
            PG8_WAIT_V(8); PG8_WAIT_L(0); PG8_BAR; PG8_MMA(1, 0, At, B0); PG8_MMA(1, 1, At, B1); PG8_BAR; PG8_SCHED;
            PG8_LDB(B0, 1, 0); PG8_LDB(B1, 1, 1); PG8_SCHED; PG8_LDA(At, 1, 0); PG8_STAGE(PG8_SA(0, 1), a2 + hstep, voffA);
            PG8_WAIT_V(8); PG8_WAIT_L(0); PG8_BAR; PG8_MMA(0, 0, At, B0); PG8_MMA(0, 1, At, B1); PG8_BAR; PG8_SCHED;
            PG8_LDA(At, 1, 1); PG8_STAGE(PG8_SB(1, 0), b3, voffB); PG8_STAGE(PG8_SB(1, 1), b3 + hstep, voffB); PG8_STAGE(PG8_SA(1, 0), a3, voffA);
            PG8_WAIT_V(8); PG8_WAIT_L(0); PG8_BAR; PG8_MMA(1, 0, At, B0); PG8_MMA(1, 1, At, B1); PG8_BAR; PG8_SCHED;
            } else {
            PG8_LDB(B0, 0, 0); PG8_SCHED; PG8_LDA(At, 0, 0); PG8_STAGE(PG8_SA(1, 1), a1 + hstep, voffA);
            PG8_WAIT_L(8); PG8_BAR; PG8_WAIT_L(0); PG8_MMA(0, 0, At, B0); PG8_BAR; PG8_SCHED;
            PG8_LDB(B1, 0, 1); PG8_STAGE(PG8_SB(0, 0), b2, voffB);
            PG8_BAR; PG8_WAIT_L(0); PG8_MMA(0, 1, At, B1); PG8_BAR;
            PG8_LDA(At, 0, 1); PG8_STAGE(PG8_SA(0, 0), a2, voffA);
            PG8_BAR; PG8_WAIT_L(0); PG8_MMA(1, 0, At, B0); PG8_BAR; PG8_SCHED;
            PG8_STAGE(PG8_SB(0, 1), b2 + hstep, voffB);
            PG8_WAIT_V(6); PG8_BAR; PG8_MMA(1, 1, At, B1); PG8_BAR;
            PG8_LDB(B0, 1, 0); PG8_SCHED; PG8_LDA(At, 1, 0); PG8_STAGE(PG8_SA(0, 1), a2 + hstep, voffA);
            PG8_WAIT_L(8); PG8_BAR; PG8_WAIT_L(0); PG8_MMA(0, 0, At, B0); PG8_BAR; PG8_SCHED;
            PG8_LDB(B1, 1, 1); PG8_STAGE(PG8_SB(1, 0), b3, voffB);
            PG8_BAR; PG8_WAIT_L(0); PG8_MMA(0, 1, At, B1); PG8_BAR;
            PG8_LDA(At, 1, 1); PG8_STAGE(PG8_SA(1, 0), a3, voffA);
            PG8_BAR; PG8_WAIT_L(0); PG8_MMA(1, 0, At, B0); PG8_BAR; PG8_SCHED;
            PG8_STAGE(PG8_SB(1, 1), b3 + hstep, voffB);
            PG8_WAIT_V(6); PG8_BAR; PG8_MMA(1, 1, At, B1); PG8_BAR;
            }
        }
        if constexpr (ALIGN_EPI) { if (wr == 0) PG8_BAR; }
        if constexpr (!Epi::AFTER_DRAIN) { E(acc, cur, wr, wc, fr, fq); S.done(cur); }
        if (!has_next) break;
#pragma unroll
        for (int a = 0; a < 2; ++a)
#pragma unroll
            for (int b = 0; b < 2; ++b)
#pragma unroll
                for (int m = 0; m < 4; ++m)
#pragma unroll
                    for (int n = 0; n < 2; ++n) acc[a][b][m][n] = (f32x4){0.f, 0.f, 0.f, 0.f};
        cur = nxt; cA = nA; cB = nB; ++ui;
        if constexpr (ALIGN_EPI) { if (wr == 1) PG8_BAR; }
    }
    PG8_WAIT_V(0);
    if constexpr (!ALIGN_EPI) { if (wr == 0) PG8_BAR; }
    PG8_BAR;
    if constexpr (Epi::AFTER_DRAIN) { E.fused(acc, cur, wr, wc, fr, fq, lds, wid, lane); S.done(cur); }
#undef PG8_SA
#undef PG8_SB
#undef PG8_STAGE
#undef PG8_LDA
#undef PG8_LDB
#undef PG8_MMA
#undef PG8_WAIT_V
#undef PG8_WAIT_L
#undef PG8_BAR
#undef PG8_SCHED
}
}

#define LAS __attribute__((address_space(3)))
typedef unsigned short bf16;
typedef short bf16x8 __attribute__((ext_vector_type(8)));
typedef short s16x4 __attribute__((ext_vector_type(4)));
typedef float f32x4 __attribute__((ext_vector_type(4)));
typedef float f32x16 __attribute__((ext_vector_type(16)));
typedef unsigned u32x4 __attribute__((ext_vector_type(4)));
typedef unsigned u32x2 __attribute__((ext_vector_type(2)));

constexpr int NB = 8, SEQ = 2048, DM = 1024, NT = NB * SEQ, MEMLEN = 256, NMEM = NB * MEMLEN;
constexpr int D_IN = 6432, NP1 = 6656, NGATE = 4096, NW1 = NP1 + NGATE;
constexpr float EPS = 1e-6f, LOG2E = 1.4426950408889634f;
constexpr float QSC = 0.125f * LOG2E;
constexpr float MSC = 0.08838834764831845f * LOG2E;
constexpr size_t MiB = 1u << 20;
constexpr size_t WS_CTL = 0;
constexpr size_t WS_ROPEC = 1 * MiB, WS_ROPES = WS_ROPEC + 256 * 1024;
constexpr size_t WS_RINV = WS_ROPES + 256 * 1024;
constexpr size_t WS_RINVM = WS_RINV + 64 * 1024;
constexpr size_t WS_BIAS1 = WS_RINVM + 8 * 1024;
constexpr size_t WS_CS = 2 * MiB;
constexpr size_t WS_KCMP = WS_CS + 512 * 1024, WS_VCMP = WS_KCMP + 256 * 1024;
constexpr size_t WS_PART = 3 * MiB;
constexpr size_t WS_SM = 4 * MiB;
constexpr size_t WS_W = 6 * MiB;
constexpr size_t W_IN = 0, W_BR = 21 * MiB, W_O = 25 * MiB, W_M = 27 * MiB, W_1K = 29 * MiB, W_1V = W_1K + 256 * 1024, W_2K = W_1V + 256 * 1024, W_2V = W_2K + 8192, W_WS = W_2K + 256 * 1024;
constexpr size_t WS_XB = 38 * MiB, WS_MEMB = 70 * MiB, WS_MKV = 74 * MiB, WS_SLOT = 78 * MiB, SLOTB = 16 * MiB;
constexpr size_t WS_KVS = 222 * MiB;
constexpr size_t WS_MERGED = 206 * MiB;
constexpr size_t WS_KX = 246 * MiB, WS_QX = 250 * MiB;
constexpr size_t WS_NEED = 256 * MiB;
constexpr int CW_Q = 64;
constexpr int LDS_BYTES = 147456;
constexpr int LDS_MISC = 143360;

__device__ __forceinline__ unsigned char* wbase(unsigned char* ws, unsigned char* dout, int layer) { return layer ? dout + 32 * MiB : ws + WS_W; }
__device__ __forceinline__ unsigned char* slot_ptr(unsigned char* ws, unsigned char* dout, int i) { return i < 9 ? ws + WS_SLOT + (size_t)i * SLOTB : dout + (size_t)(i - 9) * SLOTB; }
enum { SL_U = 0, SL_BQ = 1, SL_CQ = 2, SL_MQ = 3, SL_V = 4, SL_AZ = 5, SL_BZ = 6, SL_CK = 7, SL_CV = 8, SL_CZ = 9, SL_MZ = 10 };
__device__ __forceinline__ unsigned char* gate_ptr(unsigned char* ws, unsigned char* dout, int n) { return slot_ptr(ws, dout, 4 + n); }

__device__ __forceinline__ unsigned cvtpk(float lo, float hi) { typedef float f2 __attribute__((ext_vector_type(2))); typedef __bf16 b2 __attribute__((ext_vector_type(2))); f2 v = {lo, hi}; b2 b = __builtin_convertvector(v, b2); return __builtin_bit_cast(unsigned, b); }
__device__ __forceinline__ float bflo(unsigned w) { return __uint_as_float(w << 16); }
__device__ __forceinline__ float bfhi(unsigned w) { return __uint_as_float(w & 0xffff0000u); }
__device__ __forceinline__ float ex2(float x) { return __builtin_amdgcn_exp2f(x); }
__device__ __forceinline__ float rcp(float x) { return __builtin_amdgcn_rcpf(x); }
__device__ __forceinline__ float sigm(float x) { return rcp(1.f + ex2(-LOG2E * x)); }
__device__ __forceinline__ float silu_f(float x) { return x * sigm(x); }
__device__ __forceinline__ float gelu_f(float x) { const float u = 0.7978845608028654f * (x + 0.044715f * x * x * x); return x * sigm(2.f * u); }
__device__ __forceinline__ float wave_sum(float v) {
#pragma unroll
    for (int o = 1; o < 64; o <<= 1) v += __shfl_xor(v, o);
    return v;
}
__device__ __forceinline__ int crow(int r, int hi) { return (r & 3) + 8 * (r >> 2) + 4 * hi; }
__device__ __forceinline__ int dperm(int pp) { return (pp >> 1) + 32 * (pp & 1); }

__device__ __forceinline__ int proj_src(int p) {
    if (p < 1536) return p;
    if (p < 2432) {
        int base;
        if (p < 2048) base = 1536 + ((p - 1536) & ~63);
        else if (p < 2176) base = 2048 + ((p - 2048) & ~63);
        else if (p < 2304) base = 2304 + ((p - 2176) & ~63);
        else base = 2560 + ((p - 2304) & ~63);
        return base + dperm(p & 63);
    }
    if (p < 2560) return 2176 + (p - 2432);
    if (p < 2688) return 2432 + (p - 2560);
    if (p < 2816) return 2688 + (p - 2688);
    if (p < 3328) return 2840 + (p - 2816);
    if (p < 3840) return 3352 + (p - 3328);
    if (p < 4352) return 3864 + (p - 3840);
    if (p < 4864) return 4376 + (p - 4352);
    if (p < 5376) return 4896 + (p - 4864);
    if (p < 5888) return 5408 + (p - 5376);
    if (p < 6400) return 5920 + (p - 5888);
    if (p < 6424) return 2816 + (p - 6400);
    if (p < 6432) return 4888 + (p - 6424);
    return -1;
}

namespace pg8 {
struct EpiG1 {
    static constexpr bool PERM = true, AFTER_DRAIN = false;
    unsigned char* ws; unsigned char* dout; const float* rinv; const float* fbias; const float* ropec; const float* ropes; float* sm;
    __device__ __forceinline__ void operator()(const f32x4 (&acc)[2][2][4][2], const Unit& u, int wr, int wc, int fr, int fq) const {
        const int row0 = u.pm * 256 + wr * 64 + fr; const int bt = u.pm >> 3;
        float rv[2][4];
#pragma unroll
        for (int ai = 0; ai < 2; ++ai)
#pragma unroll
            for (int m = 0; m < 4; ++m) rv[ai][m] = rinv[row0 + ai * 128 + m * 16];
#pragma unroll
        for (int bj = 0; bj < 2; ++bj) {
            const int P = u.pn * 256 + bj * 128 + wc * 32;
            if (P >= 6432) continue;
            if (P >= 6400) {
#pragma unroll
                for (int ai = 0; ai < 2; ++ai)
#pragma unroll
                    for (int m = 0; m < 4; ++m) {
                        const int row = row0 + ai * 128 + m * 16; const float r = rv[ai][m];
                        float v[8];
#pragma unroll
                        for (int j = 0; j < 4; ++j) { v[j] = acc[ai][bj][m][0][j] * r; v[4 + j] = acc[ai][bj][m][1][j] * r; }
                        if (fq < 3) {
#pragma unroll
                            for (int j = 0; j < 8; ++j) v[j] = sigm(v[j]);
                        } else {
#pragma unroll
                            for (int j = 0; j < 8; ++j) { const float x = v[j] + fbias[j]; const float ax = fabsf(x);
                                const float sp = __logf(1.f + __expf(-ax));
                                v[j] = (fminf(x, 0.f) - sp) * LOG2E; }
                        }
                        float* d = sm + (size_t)row * 32 + 8 * fq;
                        *(f32x4*)d = (f32x4){v[0], v[1], v[2], v[3]}; *(f32x4*)(d + 4) = (f32x4){v[4], v[5], v[6], v[7]};
                    }
                continue;
            }
            const int seg = P >> 7; int kind = 0, ld = 512, col, rowadd = 0, sl = 0; float sc = 1.f; bf16* dst;
            if (seg < 4) { kind = 0; sl = SL_U; col = P; }
            else if (seg < 8) { kind = 1; sl = SL_V; col = P - 512; }
            else if (seg < 12) { kind = 0; sl = SL_AZ; col = P - 1024; }
            else if (seg < 16) { kind = 3; sl = SL_BQ; col = P - 1536; sc = QSC; }
            else if (seg < 22) { kind = seg < 19 ? 3 : 0; sl = -1; ld = 64; col = P & 63; rowadd = (bt + ((P >> 6) & 1)) * 2048; }
            else if (seg < 26) { kind = 0; sl = SL_BZ; col = P - 2816; }
            else if (seg < 30) { kind = 0; sl = SL_CQ; col = P - 3328; sc = QSC; }
            else if (seg < 34) { kind = 0; sl = SL_CK; col = P - 3840; }
            else if (seg < 38) { kind = 0; sl = SL_CV; col = P - 4352; }
            else if (seg < 42) { kind = 0; sl = SL_CZ; col = P - 4864; }
            else if (seg < 46) { kind = 0; sl = SL_MQ; col = P - 5376; sc = MSC; }
            else { kind = 0; sl = SL_MZ; col = P - 5888; }
            if (sl >= 0) dst = (bf16*)slot_ptr(ws, dout, sl); else dst = (bf16*)(ws + WS_KVS + (size_t)(seg - 16) * 4 * MiB);
            col += 8 * fq;
            const int pi0 = ((P & 63) + 8 * fq) >> 1;
#pragma unroll
            for (int ai = 0; ai < 2; ++ai) {
                f32x4 rc4[4], rs4[4];
                if (kind == 3) {
#pragma unroll
                    for (int m = 0; m < 4; ++m) { const int t = (row0 + ai * 128 + m * 16) & (SEQ - 1); rc4[m] = *(const f32x4*)(ropec + t * 32 + pi0); rs4[m] = *(const f32x4*)(ropes + t * 32 + pi0); }
                }
#pragma unroll
                for (int m = 0; m < 4; ++m) {
                    const int row = row0 + ai * 128 + m * 16; const float r = rv[ai][m];
                    float v[8];
#pragma unroll
                    for (int j = 0; j < 4; ++j) { v[j] = acc[ai][bj][m][0][j] * r; v[4 + j] = acc[ai][bj][m][1][j] * r; }
                    if (kind == 1) {
#pragma unroll
                        for (int j = 0; j < 8; ++j) v[j] = gelu_f(v[j]);
                    } else if (kind == 3) {
                        const f32x4 c4 = rc4[m], s4 = rs4[m];
#pragma unroll
                        for (int j = 0; j < 4; ++j) { const float x1 = v[2 * j], x2 = v[2 * j + 1]; v[2 * j] = x1 * c4[j] - x2 * s4[j]; v[2 * j + 1] = x1 * s4[j] + x2 * c4[j]; }
                    }
                    u32x4 w; w.x = cvtpk(v[0] * sc, v[1] * sc); w.y = cvtpk(v[2] * sc, v[3] * sc); w.z = cvtpk(v[4] * sc, v[5] * sc); w.w = cvtpk(v[6] * sc, v[7] * sc);
                    *(u32x4*)(dst + (size_t)(row + rowadd) * ld + col) = w;
                }
            }
        }
    }
};
struct EpiRowScale {
    static constexpr bool PERM = true, AFTER_DRAIN = false;
    bf16* O; int ldc; const float* rs;
    __device__ __forceinline__ void operator()(const f32x4 (&acc)[2][2][4][2], const Unit& u, int wr, int wc, int fr, int fq) const {
        const int row0 = u.pm * 256 + wr * 64 + fr;
        float rv[2][4];
#pragma unroll
        for (int ai = 0; ai < 2; ++ai)
#pragma unroll
            for (int m = 0; m < 4; ++m) rv[ai][m] = rs[row0 + ai * 128 + m * 16];
#pragma unroll
        for (int ai = 0; ai < 2; ++ai)
#pragma unroll
            for (int m = 0; m < 4; ++m) { const int row = row0 + ai * 128 + m * 16; const float r = rv[ai][m];
#pragma unroll
                for (int bj = 0; bj < 2; ++bj) { const int col = u.pn * 256 + bj * 128 + wc * 32 + 8 * fq; const f32x4 a = acc[ai][bj][m][0] * r, b = acc[ai][bj][m][1] * r;
                    u32x4 w; w.x = cvtpk(a[0], a[1]); w.y = cvtpk(a[2], a[3]); w.z = cvtpk(b[0], b[1]); w.w = cvtpk(b[2], b[3]);
                    *(u32x4*)(O + (size_t)row * ldc + col) = w; } }
    }
};
struct EpiGate {
    static constexpr bool PERM = true, AFTER_DRAIN = false;
    unsigned char* g0; unsigned char* g1; unsigned char* g2; unsigned char* g3; const float* rinv;
    __device__ __forceinline__ void operator()(const f32x4 (&acc)[2][2][4][2], const Unit& u, int wr, int wc, int fr, int fq) const {
        const int n = u.pn >> 2, e0 = (u.pn & 3) * 256; unsigned char* G = n == 0 ? g0 : n == 1 ? g1 : n == 2 ? g2 : g3;
        const int row0 = u.pm * 256 + wr * 64 + fr;
        float rv[2][4];
#pragma unroll
        for (int ai = 0; ai < 2; ++ai)
#pragma unroll
            for (int m = 0; m < 4; ++m) rv[ai][m] = rinv[row0 + ai * 128 + m * 16];
#pragma unroll
        for (int ai = 0; ai < 2; ++ai)
#pragma unroll
            for (int m = 0; m < 4; ++m) { const int row = row0 + ai * 128 + m * 16; const float r = rv[ai][m];
#pragma unroll
                for (int bj = 0; bj < 2; ++bj) { const int col = e0 + bj * 128 + wc * 32 + 8 * fq; const f32x4 a = acc[ai][bj][m][0] * r, b = acc[ai][bj][m][1] * r;
                    unsigned q[8];
#pragma unroll
                    for (int j = 0; j < 4; ++j) { q[j] = (unsigned)(sigm(a[j]) * 255.f + 0.5f); q[4 + j] = (unsigned)(sigm(b[j]) * 255.f + 0.5f); }
                    u32x2 w; w.x = q[0] | (q[1] << 8) | (q[2] << 16) | (q[3] << 24); w.y = q[4] | (q[5] << 8) | (q[6] << 16) | (q[7] << 24);
                    *(u32x2*)(G + (size_t)row * 1024 + col) = w; } }
    }
};
struct EpiMerge {
    static constexpr bool PERM = true, AFTER_DRAIN = false;
    const unsigned char* g0; const unsigned char* g1; const unsigned char* g2; const unsigned char* g3; bf16* merged;
    __device__ __forceinline__ void operator()(const f32x4 (&acc)[2][2][4][2], const Unit& u, int wr, int wc, int fr, int fq) const {
        const int n = u.pn >> 2, pn = u.pn & 3, pm = u.pm & 63; const unsigned char* G = n == 0 ? g0 : n == 1 ? g1 : n == 2 ? g2 : g3;
        const int row0 = pm * 256 + wr * 64 + fr; const int col0 = pn * 256 + wc * 32 + 8 * fq;
#pragma unroll
        for (int ai = 0; ai < 2; ++ai) {
            u32x2 gv[4][2]; u32x4 pv[4][2];
#pragma unroll
            for (int m = 0; m < 4; ++m)
#pragma unroll
                for (int bj = 0; bj < 2; ++bj) { const size_t off = (size_t)(row0 + ai * 128 + m * 16) * 1024 + col0 + bj * 128; gv[m][bj] = *(const u32x2*)(G + off); if (n > 0) pv[m][bj] = *(const u32x4*)(merged + off); }
#pragma unroll
            for (int m = 0; m < 4; ++m)
#pragma unroll
                for (int bj = 0; bj < 2; ++bj) { const size_t off = (size_t)(row0 + ai * 128 + m * 16) * 1024 + col0 + bj * 128;
                    const u32x2 g = gv[m][bj]; const f32x4 a = acc[ai][bj][m][0] * (1.f / 255.f), b = acc[ai][bj][m][1] * (1.f / 255.f);
                    float v[8] = {a[0] * (float)(g.x & 255u), a[1] * (float)((g.x >> 8) & 255u), a[2] * (float)((g.x >> 16) & 255u), a[3] * (float)(g.x >> 24),
                                  b[0] * (float)(g.y & 255u), b[1] * (float)((g.y >> 8) & 255u), b[2] * (float)((g.y >> 16) & 255u), b[3] * (float)(g.y >> 24)};
                    if (n > 0) { const u32x4 p = pv[m][bj];
                        v[0] += bflo(p.x); v[1] += bfhi(p.x); v[2] += bflo(p.y); v[3] += bfhi(p.y); v[4] += bflo(p.z); v[5] += bfhi(p.z); v[6] += bflo(p.w); v[7] += bfhi(p.w); }
                    u32x4 w; w.x = cvtpk(v[0], v[1]); w.y = cvtpk(v[2], v[3]); w.z = cvtpk(v[4], v[5]); w.w = cvtpk(v[6], v[7]);
                    *(u32x4*)(merged + off) = w; }
        }
    }
};
struct MergeOrder {
    StaticOrder base;
    __device__ void init(int G, int c) { base.init(NT, DM, G, c); }
    __device__ bool next(int i, Unit& u) const { if (!base.next(i >> 2, u)) return false; const int n = i & 3; u.pm += 64 * n; u.pn += 4 * n; return true; }
    __device__ __forceinline__ void a_ready(const Unit&) const {}
    __device__ __forceinline__ void done(const Unit&) const {}
};
struct EpiOut {
    static constexpr bool PERM = true, AFTER_DRAIN = false;
    bf16* out; float* part;
    __device__ __forceinline__ void operator()(const f32x4 (&acc)[2][2][4][2], const Unit& u, int wr, int wc, int fr, int fq) const {
        const int row0 = u.pm * 256 + wr * 64 + fr; const int col0 = u.pn * 256 + wc * 32 + 8 * fq;
#pragma unroll
        for (int ai = 0; ai < 2; ++ai)
#pragma unroll
            for (int m = 0; m < 4; ++m) { const int row = row0 + ai * 128 + m * 16; float ss = 0.f;
#pragma unroll
                for (int bj = 0; bj < 2; ++bj) { const f32x4 a = acc[ai][bj][m][0], b = acc[ai][bj][m][1];
                    ss += ((a[0] * a[0] + a[1] * a[1]) + (a[2] * a[2] + a[3] * a[3])) + ((b[0] * b[0] + b[1] * b[1]) + (b[2] * b[2] + b[3] * b[3]));
                    u32x4 w; w.x = cvtpk(a[0], a[1]); w.y = cvtpk(a[2], a[3]); w.z = cvtpk(b[0], b[1]); w.w = cvtpk(b[2], b[3]);
                    *(u32x4*)(out + (size_t)row * 1024 + col0 + bj * 128) = w; }
                ss += __shfl_xor(ss, 16); ss += __shfl_xor(ss, 32);
                if (fq == 0) part[(size_t)row * 16 + u.pn * 4 + wc] = ss; }
    }
};
}


template <int HD> struct AT {
    static constexpr int ROWB = HD * 2, CPR = HD / 8, NDS = HD / 16, NDB = HD / 32, TILEB = 64 * ROWB, NLD = TILEB / (512 * 16);
    static constexpr int BUFB = 2 * TILEB;
    static constexpr int NB = HD == 64 ? 5 : 3, DEPTH = NB - 1;
    static constexpr int CKOFF = NB * BUFB;
    static constexpr int STGOFF = 0;
    static constexpr int STGROW = ROWB + 16, STGB = 32 * STGROW;
    __device__ static __forceinline__ int fk(int row) { return HD == 64 ? ((row >> 1) & 7) : (row & 15); }
    __device__ static __forceinline__ int fv(int row) { return HD == 64 ? ((row >> 1) & 1) : (row & 3); }
};
typedef short v4i16_t __attribute__((ext_vector_type(4)));
__device__ __forceinline__ s16x4 vtr(const LAS unsigned char* p) { return __builtin_bit_cast(s16x4, __builtin_amdgcn_ds_read_tr16_b64_v4i16((LAS v4i16_t*)p)); }

template <int HD> __device__ __forceinline__ void tile_load(const bf16* g, int ld, int row0, u32x4 (&r)[AT<HD>::NLD], int tid) {
#pragma unroll
    for (int i = 0; i < AT<HD>::NLD; ++i) { const int idx = tid + 512 * i, row = idx / AT<HD>::CPR, ch = idx % AT<HD>::CPR; r[i] = *(const u32x4*)(g + (size_t)(row0 + row) * ld + ch * 8); }
}
template <int HD> __device__ __forceinline__ void tile_store_k(LAS unsigned char* kt, const u32x4 (&r)[AT<HD>::NLD], int tid) {
#pragma unroll
    for (int i = 0; i < AT<HD>::NLD; ++i) { const int idx = tid + 512 * i, row = idx / AT<HD>::CPR, ch = idx % AT<HD>::CPR; *(LAS u32x4*)(kt + row * AT<HD>::ROWB + ((ch ^ AT<HD>::fk(row)) << 4)) = r[i]; }
}
template <int HD> __device__ __forceinline__ void tile_store_v(LAS unsigned char* vt, const u32x4 (&r)[AT<HD>::NLD], int tid) {
#pragma unroll
    for (int i = 0; i < AT<HD>::NLD; ++i) { const int idx = tid + 512 * i, row = idx / AT<HD>::CPR, ch = idx % AT<HD>::CPR; *(LAS u32x4*)(vt + row * AT<HD>::ROWB + ((((ch >> 2) ^ AT<HD>::fv(row))) << 6) + ((ch & 3) << 4)) = r[i]; }
}
template <int HD> __device__ __forceinline__ void qk_tile(const LAS unsigned char* kt, const bf16x8 (&qf)[HD / 16], f32x16& s0, f32x16& s1, int lane) {
    const int r31 = lane & 31, hi = lane >> 5; const int f = AT<HD>::fk(r31); const LAS unsigned char* kb = kt + r31 * AT<HD>::ROWB;
    if constexpr (HD == 64) {
        bf16x8 k0[4], k1[4];
#pragma unroll
        for (int ds = 0; ds < 4; ++ds) { const int off = ((2 * ds + hi) ^ f) << 4; k0[ds] = *(const LAS bf16x8*)(kb + off); k1[ds] = *(const LAS bf16x8*)(kb + 32 * AT<HD>::ROWB + off); }
        __builtin_amdgcn_sched_barrier(0);
#pragma unroll
        for (int ds = 0; ds < 4; ++ds) {
            s0 = __builtin_amdgcn_mfma_f32_32x32x16_bf16(k0[ds], qf[ds], s0, 0, 0, 0);
            s1 = __builtin_amdgcn_mfma_f32_32x32x16_bf16(k1[ds], qf[ds], s1, 0, 0, 0);
        }
    } else {
#pragma unroll
        for (int ds = 0; ds < HD / 16; ++ds) {
            const int off = ((2 * ds + hi) ^ f) << 4;
            const bf16x8 k0 = *(const LAS bf16x8*)(kb + off), k1 = *(const LAS bf16x8*)(kb + 32 * AT<HD>::ROWB + off);
            s0 = __builtin_amdgcn_mfma_f32_32x32x16_bf16(k0, qf[ds], s0, 0, 0, 0);
            s1 = __builtin_amdgcn_mfma_f32_32x32x16_bf16(k1, qf[ds], s1, 0, 0, 0);
        }
    }
}
template <int HD> __device__ __forceinline__ void v_load(const LAS unsigned char* vt, bf16x8 (&vf)[HD / 8], int lane) {
    const int hi = lane >> 5, q = (lane >> 2) & 3; const int fl = HD == 64 ? (q >> 1) : q;
    const LAS unsigned char* vb = vt + (4 * hi + q) * AT<HD>::ROWB + 32 * ((lane >> 4) & 1) + 8 * (lane & 3);
#pragma unroll
    for (int db = 0; db < HD / 32; ++db) {
        const LAS unsigned char* vd = vb + ((db ^ fl) << 6);
#pragma unroll
        for (int ks = 0; ks < 4; ++ks) {
            const s16x4 lo = vtr(vd + (16 * ks) * AT<HD>::ROWB), hh = vtr(vd + (16 * ks + 8) * AT<HD>::ROWB);
            vf[db * 4 + ks] = (bf16x8){lo[0], lo[1], lo[2], lo[3], hh[0], hh[1], hh[2], hh[3]};
        }
    }
}
__device__ __forceinline__ void p_pack(const f32x16& p0, const f32x16& p1, bf16x8 (&pk)[4]) {
#pragma unroll
    for (int s = 0; s < 2; ++s) {
        u32x4 a, b;
        a.x = cvtpk(p0[8 * s + 0], p0[8 * s + 1]); a.y = cvtpk(p0[8 * s + 2], p0[8 * s + 3]); a.z = cvtpk(p0[8 * s + 4], p0[8 * s + 5]); a.w = cvtpk(p0[8 * s + 6], p0[8 * s + 7]);
        b.x = cvtpk(p1[8 * s + 0], p1[8 * s + 1]); b.y = cvtpk(p1[8 * s + 2], p1[8 * s + 3]); b.z = cvtpk(p1[8 * s + 4], p1[8 * s + 5]); b.w = cvtpk(p1[8 * s + 6], p1[8 * s + 7]);
        pk[s] = __builtin_bit_cast(bf16x8, a); pk[2 + s] = __builtin_bit_cast(bf16x8, b);
    }
}
template <int HD> __device__ __forceinline__ void pv_mma(const bf16x8 (&vf)[HD / 8], const bf16x8 (&pk)[4], f32x16 (&o)[HD / 32]) {
    __builtin_amdgcn_s_setprio(1);
#pragma unroll
    for (int db = 0; db < HD / 32; ++db)
#pragma unroll
        for (int ks = 0; ks < 4; ++ks) o[db] = __builtin_amdgcn_mfma_f32_32x32x16_bf16(vf[db * 4 + ks], pk[ks], o[db], 0, 0, 0);
    __builtin_amdgcn_s_setprio(0);
}
template <int HD> __device__ __forceinline__ void pv_tile(const LAS unsigned char* vt, const f32x16& p0, const f32x16& p1, f32x16 (&o)[HD / 32], int lane) {
    bf16x8 vf[HD / 8], pk[4]; v_load<HD>(vt, vf, lane); p_pack(p0, p1, pk); pv_mma<HD>(vf, pk, o);
}
template <int HD, bool EARLYV> __device__ __forceinline__ void softmax_pv(const LAS unsigned char* vt, f32x16& s0, f32x16& s1, f32x16 (&o)[HD / 32], float& m, float& l, int lane) {
    bf16x8 vf[HD / 8];
    if (EARLYV) { v_load<HD>(vt, vf, lane); __builtin_amdgcn_sched_barrier(0); }
    float mx = fmaxf(s0[0], s1[0]);
#pragma unroll
    for (int r = 1; r < 16; ++r) mx = fmaxf(mx, fmaxf(s0[r], s1[r]));
    mx = fmaxf(mx, __shfl_xor(mx, 32));
    const float mn = fmaxf(m, mx), ms = (mn == -INFINITY) ? 0.f : mn;
    const float al = ex2(m - ms); m = mn;
    float ps = 0.f;
#pragma unroll
    for (int r = 0; r < 16; ++r) { s0[r] = ex2(s0[r] - ms); s1[r] = ex2(s1[r] - ms); ps += s0[r] + s1[r]; }
    l = l * al + ps;
    if (__any(al != 1.f)) {
#pragma unroll
        for (int db = 0; db < HD / 32; ++db) o[db] *= al;
    }
    bf16x8 pk[4]; p_pack(s0, s1, pk);
    if (!EARLYV) v_load<HD>(vt, vf, lane);
    pv_mma<HD>(vf, pk, o);
}
__device__ __forceinline__ void glds16(const void* gsrc, unsigned lds_dst) { unsigned keep;
    asm volatile("s_mov_b32 %0, m0\n\ts_mov_b32 m0, %2\n\ts_nop 0\n\tglobal_load_lds_dwordx4 %1, off\n\ts_mov_b32 m0, %0" : "=&s"(keep) : "v"(gsrc), "s"(lds_dst) : "memory"); }
__device__ __forceinline__ void glds4(const void* gsrc, unsigned lds_dst) { unsigned keep;
    asm volatile("s_mov_b32 %0, m0\n\ts_mov_b32 m0, %2\n\ts_nop 0\n\tglobal_load_lds_dword %1, off\n\ts_mov_b32 m0, %0" : "=&s"(keep) : "v"(gsrc), "s"(lds_dst) : "memory"); }
template <int N> __device__ __forceinline__ void wait_bar() { asm volatile("s_waitcnt vmcnt(%0) lgkmcnt(0)\n\ts_barrier" :: "n"(N) : "memory"); }
typedef float f32x2 __attribute__((ext_vector_type(2)));
__device__ __forceinline__ float fadd_s(float a, float b) { float r; asm("v_add_f32_e32 %0, %1, %2" : "=v"(r) : "v"(a), "v"(b)); return r; }
__device__ __forceinline__ float max3(float a, float b, float c) { return __builtin_fmaxf(__builtin_fmaxf(a, b), c); }
__device__ __forceinline__ float xmax32(float v) { auto rr = __builtin_amdgcn_permlane32_swap(__float_as_uint(v), __float_as_uint(v), false, false); return __builtin_fmaxf(__uint_as_float(rr[0]), __uint_as_float(rr[1])); }
constexpr float SM_THR = 16.f;
template <bool CK> __device__ __forceinline__ void qk64(const LAS unsigned char* kt, const LAS unsigned char* kx, const bf16x8 (&qf)[4], const bf16x8& qx, f32x16& s0, f32x16& s1, int lane) {
    const int r31 = lane & 31, hi = lane >> 5; const int fsw = (r31 >> 1) & 7; const LAS unsigned char* kb = kt + r31 * 128;
    bf16x8 k0[4], k1[4], kx0 = {}, kx1 = {};
#pragma unroll
    for (int ds = 0; ds < 4; ++ds) { const int off = ((2 * ds + hi) ^ fsw) << 4; k0[ds] = *(const LAS bf16x8*)(kb + off); k1[ds] = *(const LAS bf16x8*)(kb + 32 * 128 + off); }
    if (CK) { kx0 = *(const LAS bf16x8*)(kx + r31 * 32 + hi * 16); kx1 = *(const LAS bf16x8*)(kx + 1024 + r31 * 32 + hi * 16); }
    __builtin_amdgcn_s_setprio(1);
    { const f32x16 z = {}; s0 = __builtin_amdgcn_mfma_f32_32x32x16_bf16(k0[0], qf[0], z, 0, 0, 0); s1 = __builtin_amdgcn_mfma_f32_32x32x16_bf16(k1[0], qf[0], z, 0, 0, 0); }
#pragma unroll
    for (int ds = 1; ds < 4; ++ds) { s0 = __builtin_amdgcn_mfma_f32_32x32x16_bf16(k0[ds], qf[ds], s0, 0, 0, 0); s1 = __builtin_amdgcn_mfma_f32_32x32x16_bf16(k1[ds], qf[ds], s1, 0, 0, 0); }
    if (CK) { s0 = __builtin_amdgcn_mfma_f32_32x32x16_bf16(kx0, qx, s0, 0, 0, 0); s1 = __builtin_amdgcn_mfma_f32_32x32x16_bf16(kx1, qx, s1, 0, 0, 0); }
    __builtin_amdgcn_s_setprio(0);
}
__device__ __forceinline__ void pv64(const LAS unsigned char* vt, const bf16x8 (&pk)[4], f32x16 (&o)[2], int lane) { bf16x8 vf[8]; v_load<64>(vt, vf, lane); pv_mma<64>(vf, pk, o); }
template <int NDB, class F> __device__ __forceinline__ bool smx(f32x16& s0, f32x16& s1, bf16x8 (&pk)[4], f32x16 (&o)[NDB], float& R, f32x16& oe, const bf16x8& onef, int& init, const F& f, int j, int lane) {
    const int hi = lane >> 5;
    const bool ok = f.lane_ok(j);
    if (f.needmask(j)) f.mask(s0, s1, j, hi);
    if (__any(R != 0.f)) { s0 -= R; s1 -= R; }
    float a = max3(s0[0], s0[1], s1[0]), b = max3(s0[2], s0[3], s1[1]); a = max3(a, s1[2], s1[3]);
#pragma unroll
    for (int r = 4; r < 16; r += 4) { a = max3(a, s0[r], s0[r + 1]); b = max3(b, s0[r + 2], s0[r + 3]); a = max3(a, s1[r], s1[r + 1]); b = max3(b, s1[r + 2], s1[r + 3]); }
    float rm = xmax32(__builtin_fmaxf(a, b));
    if (!ok) rm = -INFINITY;
    const bool fin = rm > -INFINITY;
    if (__all(rm < -140.f && (init || !fin))) return false;
    const bool need = (rm > SM_THR) || (!init && fin && rm < -SM_THR);
    if (__any(need)) {
        const float d = need ? rm : 0.f; R += d; s0 -= d; s1 -= d;
        const float fs = (need && init) ? ex2(-d) : 1.f; oe *= fs;
#pragma unroll
        for (int db = 0; db < NDB; ++db) o[db] *= fs;
    }
    init |= fin ? 1 : 0;
#pragma unroll
    for (int r = 0; r < 16; ++r) { s0[r] = ex2(s0[r]); s1[r] = ex2(s1[r]); }
    p_pack(s0, s1, pk);
    if (__any(!ok)) {
        const bf16x8 zz = {};
#pragma unroll
        for (int i = 0; i < 4; ++i) pk[i] = ok ? pk[i] : zz;
    }
#pragma unroll
    for (int ks = 0; ks < 4; ++ks) oe = __builtin_amdgcn_mfma_f32_32x32x16_bf16(onef, pk[ks], oe, 0, 0, 0);
    return true;
}
__device__ __forceinline__ void bar_lds() { asm volatile("s_waitcnt lgkmcnt(0)\n\ts_barrier" ::: "memory"); }
template <bool CK, bool DESC, class F>
__device__ __forceinline__ void attn_run64(LAS unsigned char* lds, const bf16* Kg, int ldk, const bf16* Vg, int ldv, const bf16* kxg, const bf16x8& qx, unsigned tmask,
                                           const bf16x8 (&qf)[4], f32x16 (&o)[2], float& l, const F& f, int tid, int lane) {
    l = 0.f;
    if (tmask == 0u) return;
    constexpr int NB = 5, LPT = 2 + (CK ? 1 : 0), TILEB = AT<64>::TILEB, BUFB = AT<64>::BUFB, CKOFF = AT<64>::CKOFF;
    const int wid = __builtin_amdgcn_readfirstlane(tid >> 6);
    const unsigned lds0 = (unsigned)(size_t)lds;
    const int r = 8 * wid + (lane >> 3), pc = lane & 7;
    const int koff = r * ldk + ((pc ^ AT<64>::fk(r)) << 3), voff = r * ldv + (((((pc >> 2) ^ AT<64>::fv(r)) << 2) | (pc & 3)) << 3);
    unsigned remi = tmask; int lastj = 0, ib = 0;
#define ATTN_ISSUE() do { \
        if (remi) { if (DESC) { lastj = 31 - __builtin_clz(remi); remi &= ~(1u << lastj); } else { lastj = __builtin_ctz(remi); remi &= remi - 1; } } \
        const unsigned kdst_ = lds0 + ib * BUFB + wid * 1024; \
        glds16(Kg + (size_t)(64 * lastj) * ldk + koff, (unsigned)__builtin_amdgcn_readfirstlane(kdst_)); \
        glds16(Vg + (size_t)(64 * lastj) * ldv + voff, (unsigned)__builtin_amdgcn_readfirstlane(kdst_ + TILEB)); \
        if (CK) glds4((const unsigned char*)kxg + (size_t)(64 * lastj) * 32 + wid * 256 + lane * 4, (unsigned)__builtin_amdgcn_readfirstlane(lds0 + CKOFF + ib * 2048 + wid * 256)); \
        ib = ib + 1 == NB ? 0 : ib + 1; } while (0)
    ATTN_ISSUE(); ATTN_ISSUE(); ATTN_ISSUE(); ATTN_ISSUE();
    unsigned remq = tmask; int cb = 0, jc = 0;
    float R = 0.f; f32x16 oe = {}; int init = 0;
    bf16x8 onef = {}; if ((lane & 31) == 0) onef = (bf16x8){0x3f80, 0x3f80, 0x3f80, 0x3f80, 0x3f80, 0x3f80, 0x3f80, 0x3f80};
    while (remq) {
        wait_bar<3 * LPT>();
        ATTN_ISSUE();
        if (DESC) { jc = 31 - __builtin_clz(remq); remq &= ~(1u << jc); } else { jc = __builtin_ctz(remq); remq &= remq - 1; }
        if (f.active(jc)) {
            f32x16 s0, s1; bf16x8 pk[4], vf[8];
            qk64<CK>(lds + cb * BUFB, lds + CKOFF + cb * 2048, qf, qx, s0, s1, lane);
            v_load<64>(lds + cb * BUFB + TILEB, vf, lane);
            if (smx<2>(s0, s1, pk, o, R, oe, onef, init, f, jc, lane)) pv_mma<64>(vf, pk, o);
        }
        cb = cb + 1 == NB ? 0 : cb + 1;
    }
    wait_bar<0>();
    { auto rr = __builtin_amdgcn_permlane32_swap(__float_as_uint(oe[0]), __float_as_uint(oe[0]), false, false); l = __uint_as_float(rr[0]); }
#undef ATTN_ISSUE
}
template <int HD, class F>
__device__ __forceinline__ void attn_run128(LAS unsigned char* lds, const bf16* Kg, int ldk, const bf16* Vg, int ldv, unsigned tmask,
                                            const bf16x8 (&qf)[HD / 16], f32x16 (&o)[HD / 32], float& l, const F& f, int tid, int lane) {
    l = 0.f;
    if (tmask == 0u) return;
    constexpr int NB = AT<HD>::NB, D = AT<HD>::DEPTH, PPW = HD / 64, LPT = 2 * PPW;
    const int wid = __builtin_amdgcn_readfirstlane(tid >> 6);
    const unsigned lds0 = (unsigned)(size_t)lds;
    int koff[PPW], voff[PPW];
#pragma unroll
    for (int p = 0; p < PPW; ++p) { const int piece = wid * PPW + p; const int r = 4 * piece + (lane >> 4); const int pc = lane & 15;
        koff[p] = r * ldk + ((pc ^ AT<HD>::fk(r)) << 3); const int blk = (pc >> 2) ^ AT<HD>::fv(r); voff[p] = r * ldv + (((blk << 2) | (pc & 3)) << 3); }
    unsigned remi = tmask; int lastj = 0, ib = 0;
#define ATTN_ISSUE() do { \
        if (remi) { lastj = __builtin_ctz(remi); remi &= remi - 1; } \
        const unsigned kdst_ = lds0 + ib * AT<HD>::BUFB + wid * PPW * 1024, vdst_ = kdst_ + AT<HD>::TILEB; \
        _Pragma("unroll") for (int p = 0; p < PPW; ++p) { glds16(Kg + (size_t)(64 * lastj) * ldk + koff[p], (unsigned)__builtin_amdgcn_readfirstlane(kdst_ + p * 1024)); \
            glds16(Vg + (size_t)(64 * lastj) * ldv + voff[p], (unsigned)__builtin_amdgcn_readfirstlane(vdst_ + p * 1024)); } \
        ib = ib + 1 == NB ? 0 : ib + 1; } while (0)
#pragma unroll
    for (int k = 0; k < D; ++k) ATTN_ISSUE();
    unsigned remp = tmask; int pb = 0; float R = 0.f; f32x16 oe = {}; int init = 0;
    bf16x8 onef = {}; if ((lane & 31) == 0) onef = (bf16x8){0x3f80, 0x3f80, 0x3f80, 0x3f80, 0x3f80, 0x3f80, 0x3f80, 0x3f80};
    while (remp) {
        wait_bar<(D - 1) * LPT>();
        ATTN_ISSUE();
        const int j = __builtin_ctz(remp); remp &= remp - 1;
        if (f.active(j)) { const LAS unsigned char* kt = lds + pb * AT<HD>::BUFB; f32x16 s0 = {}, s1 = {}; bf16x8 pk[4]; qk_tile<HD>(kt, qf, s0, s1, lane);
            if (smx<HD / 32>(s0, s1, pk, o, R, oe, onef, init, f, j, lane)) { bf16x8 vf[HD / 8]; v_load<HD>(kt + AT<HD>::TILEB, vf, lane); pv_mma<HD>(vf, pk, o); } }
        pb = pb + 1 == NB ? 0 : pb + 1;
    }
    wait_bar<0>();
    { auto rr = __builtin_amdgcn_permlane32_swap(__float_as_uint(oe[0]), __float_as_uint(oe[0]), false, false); l = __uint_as_float(rr[0]); }
#undef ATTN_ISSUE
}
template <int HD> __device__ __forceinline__ void attn_store(LAS unsigned char* stg, const f32x16 (&o)[HD / 32], const bf16* zg, int ldz, bf16* outg, int ldo, int lane) {
    const int q = lane & 31, hi = lane >> 5;
#pragma unroll
    for (int db = 0; db < HD / 32; ++db)
#pragma unroll
        for (int g = 0; g < 4; ++g) { u32x2 w; w.x = cvtpk(o[db][4 * g], o[db][4 * g + 1]); w.y = cvtpk(o[db][4 * g + 2], o[db][4 * g + 3]);
            *(LAS u32x2*)(stg + q * AT<HD>::STGROW + (32 * db + 8 * g + 4 * hi) * 2) = w; }
    constexpr int CPR = AT<HD>::CPR, RPP = 64 / CPR, NIT = 32 / RPP;
    u32x4 zs[NIT];
#pragma unroll
    for (int it = 0; it < NIT; ++it) { const int row = it * RPP + lane / CPR, ch = lane % CPR; zs[it] = *(const u32x4*)(zg + (size_t)row * ldz + ch * 8); }
#pragma unroll
    for (int it = 0; it < NIT; ++it) { const int row = it * RPP + lane / CPR, ch = lane % CPR;
        const u32x4 v = *(const LAS u32x4*)(stg + row * AT<HD>::STGROW + ch * 16); const u32x4 z = zs[it];
        u32x4 w; w.x = cvtpk(bflo(v.x) * silu_f(bflo(z.x)), bfhi(v.x) * silu_f(bfhi(z.x))); w.y = cvtpk(bflo(v.y) * silu_f(bflo(z.y)), bfhi(v.y) * silu_f(bfhi(z.y)));
        w.z = cvtpk(bflo(v.z) * silu_f(bflo(z.z)), bfhi(v.z) * silu_f(bfhi(z.z))); w.w = cvtpk(bflo(v.w) * silu_f(bflo(z.w)), bfhi(v.w) * silu_f(bfhi(z.w)));
        *(u32x4*)(outg + (size_t)row * ldo + ch * 8) = w; }
}
template <int HD> __device__ __forceinline__ void load_q(const bf16* qrow, bf16x8 (&qf)[HD / 16], int hi) {
#pragma unroll
    for (int ds = 0; ds < HD / 16; ++ds) qf[ds] = *(const bf16x8*)(qrow + 16 * ds + 8 * hi);
}
__device__ __forceinline__ float lsum_inv(float l) { return l > 0.f ? 1.f / l : 0.f; }
__device__ __forceinline__ float lsum_inv_halves(float l) { const float lt = l + __shfl_xor(l, 32); return lt > 0.f ? 1.f / lt : 0.f; }

struct FNone { __device__ __forceinline__ bool active(int) const { return true; } __device__ __forceinline__ bool lane_ok(int) const { return true; } __device__ __forceinline__ bool needmask(int) const { return false; }
    __device__ __forceinline__ void mask(f32x16&, f32x16&, int, int) const {} };
struct FForget {
    int tq, qmin, qmax;
    __device__ __forceinline__ bool active(int j) const { return 64 * j <= qmax; }
    __device__ __forceinline__ bool lane_ok(int) const { return true; }
    __device__ __forceinline__ bool needmask(int j) const { return 64 * j + 63 > qmin; }
    __device__ __forceinline__ void mask(f32x16& s0, f32x16& s1, int j, int hi) const {
        const int kb = 64 * j;
#pragma unroll
        for (int r = 0; r < 16; ++r) { const int k0 = kb + crow(r, hi); if (k0 > tq) s0[r] = -INFINITY; if (k0 + 32 > tq) s1[r] = -INFINITY; }
    }
};
struct FSelWin {
    unsigned sel; int tq, cur, mode, lo;
    __device__ __forceinline__ bool active(int j) const { return mode ? true : (__any((sel >> j) & 1u) != 0); }
    __device__ __forceinline__ bool lane_ok(int j) const { return mode ? true : (((sel >> j) & 1u) != 0u); }
    __device__ __forceinline__ bool needmask(int j) const { return (j == cur) || (mode && j == cur - 4); }
    __device__ __forceinline__ void mask(f32x16& s0, f32x16& s1, int j, int hi) const {
        const int kb = 64 * j;
#pragma unroll
        for (int r = 0; r < 16; ++r) { const int k0 = kb + crow(r, hi); if (k0 > tq || k0 <= lo) s0[r] = -INFINITY; if (k0 + 32 > tq || k0 + 32 <= lo) s1[r] = -INFINITY; }
    }
};

struct Ptrs {
    const float* in[21]; unsigned char* out; unsigned char* ws;
};
__device__ __forceinline__ void fa_item(const Ptrs& P, LAS unsigned char* lds, int b, int h, int qt, int tid, int lane, int wid) {
    bf16* CQ = (bf16*)slot_ptr(P.ws, P.out, SL_CQ); const bf16* CK = (const bf16*)slot_ptr(P.ws, P.out, SL_CK); const bf16* CV = (const bf16*)slot_ptr(P.ws, P.out, SL_CV); const bf16* CZ = (const bf16*)slot_ptr(P.ws, P.out, SL_CZ);
    const bf16* KX = (const bf16*)(P.ws + WS_KX) + (size_t)(b * 8 + h) * SEQ * 16; const bf16* QX = (const bf16*)(P.ws + WS_QX) + (size_t)(b * 8 + h) * SEQ * 8;
    const int hi = lane >> 5, t0 = 256 * qt + 32 * wid, tq = t0 + (lane & 31);
    const size_t rowq = (size_t)(b * SEQ + tq) * 512 + h * 64;
    bf16x8 qf[4]; load_q<64>(CQ + rowq, qf, hi);
    f32x16 o[2] = {}; float l = 0.f;
    bf16x8 qx = {}; if (hi == 0) qx = *(const bf16x8*)(QX + (size_t)tq * 8);
    FForget f; f.tq = tq; f.qmin = t0; f.qmax = t0 + 31;
    const int ntile = 4 * qt + 4; const unsigned tmask = ntile >= 32 ? 0xffffffffu : ((1u << ntile) - 1u);
    attn_run64<true, true>(lds, CK + (size_t)b * SEQ * 512 + h * 64, 512, CV + (size_t)b * SEQ * 512 + h * 64, 512, KX, qx, tmask, qf, o, l, f, tid, lane);
    const float li = lsum_inv(l);
    o[0] *= li; o[1] *= li;
    const size_t row0 = (size_t)(b * SEQ + t0) * 512 + h * 64;
    attn_store<64>(lds + AT<64>::STGOFF + wid * AT<64>::STGB, o, CZ + row0, 512, CQ + row0, 512, lane);
}
__device__ __forceinline__ void mem_item(const Ptrs& P, LAS unsigned char* lds, int b, int h, int qt, int tid, int lane, int wid) {
    bf16* MQ = (bf16*)slot_ptr(P.ws, P.out, SL_MQ); const bf16* MZ = (const bf16*)slot_ptr(P.ws, P.out, SL_MZ); const bf16* MKV = (const bf16*)(P.ws + WS_MKV);
    const int hi = lane >> 5, t0 = 256 * qt + 32 * wid, tq = t0 + (lane & 31);
    bf16x8 qf[8]; load_q<128>(MQ + (size_t)(b * SEQ + tq) * 512 + h * 128, qf, hi);
    f32x16 o[4] = {}; float l = 0.f; FNone f; const bf16x8 qx0 = {};
    attn_run128<128>(lds, MKV + (size_t)b * MEMLEN * 1024 + h * 128, 1024, MKV + (size_t)b * MEMLEN * 1024 + 512 + h * 128, 1024, 0xfu, qf, o, l, f, tid, lane);
    const float li = lsum_inv(l);
#pragma unroll
    for (int db = 0; db < 4; ++db) o[db] *= li;
    const size_t row0 = (size_t)(b * SEQ + t0) * 512 + h * 128;
    attn_store<128>(lds + AT<128>::STGOFF + wid * AT<128>::STGB, o, MZ + row0, 512, MQ + row0, 512, lane);
}
constexpr int NSA_IMPQ = 32768;
constexpr int NSA_IMPL = NSA_IMPQ + 32768;
constexpr int NSA_IMPF = NSA_IMPL + 32768;
constexpr int NSA_SEL = NSA_IMPF + 8192;
__device__ __forceinline__ void nsa_item(const Ptrs& P, LAS unsigned char* lds, int b, int kvh, int cur, int tid, int lane, int wid) {
    bf16* BQ = (bf16*)slot_ptr(P.ws, P.out, SL_BQ); const bf16* BZ = (const bf16*)slot_ptr(P.ws, P.out, SL_BZ);
    const bf16* KVS = (const bf16*)(P.ws + WS_KVS); const size_t hoff = (size_t)(b * 2 + kvh) * SEQ * 64;
    const bf16* KS = KVS + 1 * 2 * MiB + hoff; const bf16* KW = KVS + 2 * 2 * MiB + hoff; const bf16* VS = KVS + 4 * 2 * MiB + hoff; const bf16* VW = KVS + 5 * 2 * MiB + hoff;
    const bf16* KCMP = (const bf16*)(P.ws + WS_KCMP) + (size_t)(b * 2 + kvh) * 128 * 64; const bf16* VCMP = (const bf16*)(P.ws + WS_VCMP) + (size_t)(b * 2 + kvh) * 128 * 64;
    const float* SM = (const float*)(P.ws + WS_SM);
    const int hi = lane >> 5, g = wid >> 1, pos = 32 * (wid & 1) + (lane & 31), tq = 64 * cur + pos, hq = kvh * 4 + g;
    const size_t rowq = (size_t)(b * SEQ + tq) * 512 + hq * 64;
    bf16x8 qf[4]; load_q<64>(BQ + rowq, qf, hi);
    const float* gl = SM + (size_t)(b * SEQ + tq) * 32 + hq * 3; const float g0 = gl[0], g12[2] = {gl[1], gl[2]};
    f32x16 res[2] = {};
    {
        const int ntc = (4 * cur + 2) / 64 + 1;
        u32x4 kr[2][1], vr[2][1];
#pragma unroll
        for (int tl = 0; tl < 2; ++tl) if (tl < ntc) { tile_load<64>(KCMP, 64, 64 * tl, kr[tl], tid); tile_load<64>(VCMP, 64, 64 * tl, vr[tl], tid); }
#pragma unroll
        for (int tl = 0; tl < 2; ++tl) if (tl < ntc) { tile_store_k<64>(lds + tl * AT<64>::BUFB, kr[tl], tid); tile_store_v<64>(lds + tl * AT<64>::BUFB + AT<64>::TILEB, vr[tl], tid); }
        __syncthreads();
        f32x16 o[2] = {}; float m = -INFINITY, l = 0.f;
#pragma unroll 1
        for (int tl = 0; tl < ntc; ++tl) {
            f32x16 s0 = {}, s1 = {};
            qk_tile<64>(lds + tl * AT<64>::BUFB, qf, s0, s1, lane);
#pragma unroll
            for (int r = 0; r < 16; ++r) { const int c0 = 64 * tl + crow(r, hi); if (16 * c0 + 31 > tq) s0[r] = -INFINITY; if (16 * (c0 + 32) + 31 > tq) s1[r] = -INFINITY; }
            softmax_pv<64, true>(lds + tl * AT<64>::BUFB + AT<64>::TILEB, s0, s1, o, m, l, lane);
        }
        const float li = lsum_inv_halves(l), ms = (m == -INFINITY) ? 0.f : m;
        res[0] = o[0] * (g0 * li); res[1] = o[1] * (g0 * li);
        LAS float* impq = (LAS float*)(lds + NSA_IMPQ) + g * 2048 + pos; LAS float* impl = (LAS float*)(lds + NSA_IMPL) + g * 2048 + pos;
#pragma unroll 1
        for (int tl = 0; tl < 2; ++tl) {
            f32x16 s0 = {}, s1 = {};
            if (tl < ntc) { qk_tile<64>(lds + tl * AT<64>::BUFB, qf, s0, s1, lane);
#pragma unroll
                for (int r = 0; r < 16; ++r) { const int c0 = 64 * tl + crow(r, hi); s0[r] = (16 * c0 + 31 > tq) ? 0.f : ex2(s0[r] - ms) * li; s1[r] = (16 * (c0 + 32) + 31 > tq) ? 0.f : ex2(s1[r] - ms) * li; } }
#pragma unroll
            for (int gq = 0; gq < 4; ++gq) { const int j0 = 16 * tl + 2 * gq + hi;
                impq[j0 * 64] = (s0[4 * gq] + s0[4 * gq + 1]) + (s0[4 * gq + 2] + s0[4 * gq + 3]); impl[j0 * 64] = s0[4 * gq + 3];
                impq[(j0 + 8) * 64] = (s1[4 * gq] + s1[4 * gq + 1]) + (s1[4 * gq + 2] + s1[4 * gq + 3]); impl[(j0 + 8) * 64] = s1[4 * gq + 3]; }
        }
    }
    __syncthreads();
    {
        const int p = tid >> 3, sub = tid & 7; const int e0 = p * 32 + 4 * sub;
        const LAS float* bq = (const LAS float*)(lds + NSA_IMPQ) + (4 * sub) * 64 + p; const LAS float* bl = (const LAS float*)(lds + NSA_IMPL) + (4 * sub) * 64 + p; LAS float* impf = (LAS float*)(lds + NSA_IMPF) + e0;
        float v[4] = {0.f, 0.f, 0.f, 0.f};
#pragma unroll
        for (int gg = 0; gg < 4; ++gg) { const float cm1 = sub > 0 ? bl[gg * 2048 - 64] : 0.f;
            v[0] += bq[gg * 2048] + cm1; v[1] += bq[gg * 2048 + 64] + bl[gg * 2048]; v[2] += bq[gg * 2048 + 128] + bl[gg * 2048 + 64]; v[3] += bq[gg * 2048 + 192] + bl[gg * 2048 + 128]; }
#pragma unroll
        for (int i = 0; i < 4; ++i) { const int j = 4 * sub + i; if (j == 0 || j == cur || j == cur - 1) v[i] = 1e9f; else if (j > cur) v[i] = -1e30f; }
        *(LAS f32x4*)impf = (f32x4){v[0], v[1], v[2], v[3]};
    }
    __syncthreads();
    {
        const int p = tid >> 3, sub = tid & 7; LAS float* impf = (LAS float*)(lds + NSA_IMPF) + p * 32; LAS unsigned* selw = (LAS unsigned*)(lds + NSA_SEL);
        float mine[4]; int rank[4] = {0, 0, 0, 0};
#pragma unroll
        for (int i = 0; i < 4; ++i) mine[i] = impf[4 * sub + i];
        for (int jj = 0; jj < 32; ++jj) { const float v = impf[jj];
#pragma unroll
            for (int i = 0; i < 4; ++i) { const int j = 4 * sub + i; rank[i] += (v > mine[i] || (v == mine[i] && jj < j)) ? 1 : 0; } }
        unsigned bits = 0u;
#pragma unroll
        for (int i = 0; i < 4; ++i) { const int j = 4 * sub + i; if (rank[i] < 8 && j <= cur) bits |= 1u << j; }
        bits |= __shfl_xor(bits, 1); bits |= __shfl_xor(bits, 2); bits |= __shfl_xor(bits, 4);
        if (sub == 0) selw[p] = bits;
    }
    __syncthreads();
    unsigned selm, uni;
    {
        LAS unsigned* selw = (LAS unsigned*)(lds + NSA_SEL);
        selm = selw[pos];
        unsigned u = selw[lane];
#pragma unroll
        for (int o = 1; o < 64; o <<= 1) u |= __shfl_xor(u, o);
        uni = __builtin_amdgcn_readfirstlane(u);
    }
    const int j0w = cur >= 4 ? cur - 4 : 0; const unsigned hiM = cur >= 31 ? 0xffffffffu : ((2u << cur) - 1u); const unsigned wmask = hiM & ~((1u << j0w) - 1u);
#pragma unroll 1
    for (int br = 0; br < 2; ++br) {
        f32x16 o[2] = {}; float l = 0.f; FSelWin f; f.sel = selm; f.tq = tq; f.cur = cur; f.mode = br; f.lo = br ? tq - 256 : -1; const bf16x8 qx0 = {};
        attn_run64<false, false>(lds, br ? KW : KS, 64, br ? VW : VS, 64, nullptr, qx0, br ? wmask : uni, qf, o, l, f, tid, lane);
        const float li = lsum_inv(l) * (br ? g12[1] : g12[0]); res[0] += o[0] * li; res[1] += o[1] * li;
    }
    const size_t row0 = (size_t)(b * SEQ + 64 * cur + 32 * (wid & 1)) * 512 + hq * 64;
    attn_store<64>(lds + AT<64>::STGOFF + wid * AT<64>::STGB, res, BZ + row0, 512, BQ + row0, 512, lane);
    __syncthreads();
}
__device__ __forceinline__ void cmp_item(const Ptrs& P, LAS unsigned char* lds, int layer, int b, int kvh, int which, int rq, int lane, int wid) {
    const bf16* W = (const bf16*)wbase(P.ws, P.out, layer);
    const bf16* A = (const bf16*)(P.ws + WS_KVS) + (size_t)(which ? 3 : 0) * 2 * MiB + (size_t)(b * 2 + kvh) * SEQ * 64;
    const bf16* W1 = (const bf16*)((const unsigned char*)W + (which ? W_1V : W_1K)); const bf16* W2 = (const bf16*)((const unsigned char*)W + (which ? W_2V : W_2K));
    const float* bias1 = (const float*)(P.ws + WS_BIAS1) + which * 64;
    bf16* O = (bf16*)(P.ws + (which ? WS_VCMP : WS_KCMP)) + (size_t)(b * 2 + kvh) * 128 * 64;
    const int rt = wid & 1, k4 = wid >> 1, c = 32 * rq + 16 * rt + (lane & 15), kq = lane >> 4;
    f32x4 acc[4] = {};
    const bf16* ap = A + (size_t)c * 1024 + 8 * kq + 512 * k4; const bf16* wp = W1 + (size_t)(lane & 15) * 2048 + 8 * kq + 512 * k4;
#pragma unroll 4
    for (int ks = 0; ks < 16; ++ks) {
        const bf16x8 af = *(const bf16x8*)(ap + 32 * ks);
#pragma unroll
        for (int et = 0; et < 4; ++et) { const bf16x8 wf = *(const bf16x8*)(wp + (size_t)et * 16 * 2048 + 32 * ks); acc[et] = __builtin_amdgcn_mfma_f32_16x16x32_bf16(wf, af, acc[et], 0, 0, 0); }
    }
    LAS float* part = (LAS float*)lds + ((k4 * 2 + rt) * 64 + lane) * 16;
#pragma unroll
    for (int et = 0; et < 4; ++et) *(LAS f32x4*)(part + 4 * et) = acc[et];
    __syncthreads();
    if (k4 == 0) {
#pragma unroll
        for (int kk = 1; kk < 4; ++kk)
#pragma unroll
            for (int et = 0; et < 4; ++et) acc[et] += *(const LAS f32x4*)(part + kk * 2 * 64 * 16 + 4 * et);
        bf16x8 hf[2];
#pragma unroll
        for (int s = 0; s < 2; ++s) { u32x4 w; float v[8];
#pragma unroll
            for (int i = 0; i < 4; ++i) { v[i] = silu_f(acc[2 * s][i] + bias1[32 * s + 4 * kq + i]); v[4 + i] = silu_f(acc[2 * s + 1][i] + bias1[32 * s + 16 + 4 * kq + i]); }
            w.x = cvtpk(v[0], v[1]); w.y = cvtpk(v[2], v[3]); w.z = cvtpk(v[4], v[5]); w.w = cvtpk(v[6], v[7]); hf[s] = __builtin_bit_cast(bf16x8, w); }
        f32x4 o2[4] = {};
#pragma unroll
        for (int et = 0; et < 4; ++et)
#pragma unroll
            for (int s = 0; s < 2; ++s) { const bf16* w2r = W2 + (size_t)(16 * et + (lane & 15)) * 64 + 32 * s + 4 * kq;
                const u32x2 a = *(const u32x2*)w2r, bq = *(const u32x2*)(w2r + 16); u32x4 w; w.x = a.x; w.y = a.y; w.z = bq.x; w.w = bq.y;
                o2[et] = __builtin_amdgcn_mfma_f32_16x16x32_bf16(__builtin_bit_cast(bf16x8, w), hf[s], o2[et], 0, 0, 0); }
#pragma unroll
        for (int et = 0; et < 4; ++et) { u32x2 w; w.x = cvtpk(o2[et][0], o2[et][1]); w.y = cvtpk(o2[et][2], o2[et][3]); if (c == 127) { w.x = 0u; w.y = 0u; }
            *(u32x2*)(O + (size_t)c * 64 + 16 * et + 4 * kq) = w; }
    }
}
constexpr int GM_ROWB = 1024 + 16;
__device__ __forceinline__ void gmlp_item(const Ptrs& P, LAS unsigned char* lds, int layer, int b, int ch, int tid, int lane, int wid) {
    bf16* U = (bf16*)slot_ptr(P.ws, P.out, SL_U); const bf16* V = (const bf16*)slot_ptr(P.ws, P.out, SL_V); const bf16* AZ = (const bf16*)slot_ptr(P.ws, P.out, SL_AZ);
    const bf16* WSP = (const bf16*)(wbase(P.ws, P.out, layer) + W_WS); const float* lng = P.in[7] + layer * 512; const float* lnb = P.in[8] + layer * 512; const float* bs = P.in[10] + layer * 512;
    const size_t r0 = (size_t)b * SEQ + 128 * ch;
    {
        float gam[8], bet[8];
#pragma unroll
        for (int i = 0; i < 8; ++i) { gam[i] = lng[8 * lane + i]; bet[i] = lnb[8 * lane + i]; }
        u32x4 raws[16];
#pragma unroll
        for (int rr = 0; rr < 16; ++rr) raws[rr] = *(const u32x4*)(V + (r0 + 16 * wid + rr) * 512 + 8 * lane);
        float s1[16], s2[16];
#pragma unroll
        for (int rr = 0; rr < 16; ++rr) { const u32x4 raw = raws[rr]; const float x[8] = {bflo(raw.x), bfhi(raw.x), bflo(raw.y), bfhi(raw.y), bflo(raw.z), bfhi(raw.z), bflo(raw.w), bfhi(raw.w)};
            float a = 0.f, q = 0.f;
#pragma unroll
            for (int i = 0; i < 8; ++i) { a += x[i]; q += x[i] * x[i]; }
            s1[rr] = a; s2[rr] = q; }
#pragma unroll
        for (int o = 1; o < 64; o <<= 1) {
#pragma unroll
            for (int rr = 0; rr < 16; ++rr) { s1[rr] += __shfl_xor(s1[rr], o); s2[rr] += __shfl_xor(s2[rr], o); }
        }
#pragma unroll
        for (int rr = 0; rr < 16; ++rr) { const int row = 16 * wid + rr; const u32x4 raw = raws[rr];
            const float x[8] = {bflo(raw.x), bfhi(raw.x), bflo(raw.y), bfhi(raw.y), bflo(raw.z), bfhi(raw.z), bflo(raw.w), bfhi(raw.w)};
            const float mu = s1[rr] * (1.f / 512.f); const float var = fmaxf(s2[rr] * (1.f / 512.f) - mu * mu, 0.f); const float rstd = 1.f / sqrtf(var + EPS);
            float y[8];
#pragma unroll
            for (int i = 0; i < 8; ++i) y[i] = (x[i] - mu) * rstd * gam[i] + bet[i];
            u32x4 w; w.x = cvtpk(y[0], y[1]); w.y = cvtpk(y[2], y[3]); w.z = cvtpk(y[4], y[5]); w.w = cvtpk(y[6], y[7]);
            *(LAS u32x4*)(lds + row * GM_ROWB + 16 * lane) = w; }
    }
    __syncthreads();
    const int tl = lane & 15, kq = lane >> 4, t = 16 * wid + tl; const int nks = (16 * wid + 15) / 32 + 1;
    const LAS unsigned char* vb = lds + (8 * kq + ((lane >> 2) & 3)) * GM_ROWB + 8 * (lane & 3);
    for (int g = 0; g < 4; ++g) {
        f32x4 acc[8] = {};
        const bf16* wrow = WSP + (size_t)(g * 128 + t) * 128 + 8 * kq;
        bf16x8 wfs[4];
#pragma unroll
        for (int ks = 0; ks < 4; ++ks) wfs[ks] = *(const bf16x8*)(wrow + 32 * (ks < nks ? ks : 0));
        u32x2 uus[8], zzs[8];
#pragma unroll
        for (int dt = 0; dt < 8; ++dt) { const size_t off = (r0 + t) * 512 + g * 128 + 16 * dt + 4 * kq; uus[dt] = *(const u32x2*)(U + off); zzs[dt] = *(const u32x2*)(AZ + off); }
        const float bsv = bs[g * 128 + t];
#pragma unroll
        for (int ks = 0; ks < 4; ++ks) {
            if (ks < nks) {
                const bf16x8 wf = wfs[ks];
#pragma unroll
                for (int dt = 0; dt < 8; ++dt) { const LAS unsigned char* p = vb + (32 * ks) * GM_ROWB + (g * 128 + 16 * dt) * 2;
                    const s16x4 lo = vtr(p), hh = vtr(p + 4 * GM_ROWB); const bf16x8 vf = (bf16x8){lo[0], lo[1], lo[2], lo[3], hh[0], hh[1], hh[2], hh[3]};
                    acc[dt] = __builtin_amdgcn_mfma_f32_16x16x32_bf16(vf, wf, acc[dt], 0, 0, 0); }
            }
        }
#pragma unroll
        for (int dt = 0; dt < 8; ++dt) { const size_t off = (r0 + t) * 512 + g * 128 + 16 * dt + 4 * kq; const u32x2 uu = uus[dt], zz = zzs[dt];
            u32x2 w; w.x = cvtpk((acc[dt][0] + bsv) * gelu_f(bflo(uu.x)) * silu_f(bflo(zz.x)), (acc[dt][1] + bsv) * gelu_f(bfhi(uu.x)) * silu_f(bfhi(zz.x))); w.y = cvtpk((acc[dt][2] + bsv) * gelu_f(bflo(uu.y)) * silu_f(bflo(zz.y)), (acc[dt][3] + bsv) * gelu_f(bfhi(uu.y)) * silu_f(bfhi(zz.y)));
            *(u32x2*)(U + off) = w; }
    }
    __syncthreads();
}
__device__ __forceinline__ void cumsum_item(const Ptrs& P, LAS unsigned char* lds, int b, int h, int tid, int lane, int wid) {
    const float* SM = (const float*)(P.ws + WS_SM) + ((size_t)b * SEQ + 4 * tid) * 32 + 24 + h;
    bf16* KX = (bf16*)(P.ws + WS_KX) + ((size_t)(b * 8 + h) * SEQ + 4 * tid) * 16; bf16* QX = (bf16*)(P.ws + WS_QX) + ((size_t)(b * 8 + h) * SEQ + 4 * tid) * 8;
    LAS float* wsum = (LAS float*)(lds + LDS_MISC + 64);
    float v[4];
#pragma unroll
    for (int i = 0; i < 4; ++i) v[i] = SM[(size_t)i * 32];
    v[1] += v[0]; v[2] += v[1]; v[3] += v[2];
    float tot = v[3];
#pragma unroll
    for (int o = 1; o < 64; o <<= 1) { const float x = __shfl_up(tot, o); if (lane >= o) tot += x; }
    if (lane == 63) wsum[wid] = tot;
    __syncthreads();
    float base = tot - v[3];
    for (int w = 0; w < wid; ++w) base += wsum[w];
#pragma unroll
    for (int i = 0; i < 4; ++i) { const float c = v[i] + base;
        const unsigned h0 = cvtpk(c, 0.f) & 0xffffu; const float r1 = c - __uint_as_float(h0 << 16);
        const unsigned h1 = cvtpk(r1, 0.f) & 0xffffu; const float r2 = r1 - __uint_as_float(h1 << 16);
        const unsigned h2 = cvtpk(r2, 0.f) & 0xffffu;
        const unsigned ONE = 0x3f80u;
        u32x4 q; q.x = ONE | (ONE << 16); q.y = ONE | (h0 << 16); q.z = h1 | (h2 << 16); q.w = 0u;
        *(u32x4*)(QX + i * 8) = q;
        u32x4 k; k.x = (h0 ^ 0x8000u) | ((h1 ^ 0x8000u) << 16); k.y = (h2 ^ 0x8000u) | (ONE << 16); k.z = ONE | (ONE << 16); k.w = 0u;
        *(u32x4*)(KX + i * 16) = k; *(u32x4*)(KX + i * 16 + 8) = (u32x4){0u, 0u, 0u, 0u}; }
}


__device__ __forceinline__ void prep_item(const float* W, int K, int Nsrc, const float* scale, bf16* out, int row_off, int P, bool projmap, LAS float* scr, int item, int lane) {
    const int nblk = P / 32, kb = item / nblk, nb = item % nblk, k0 = 64 * kb, n0 = 32 * nb;
    const int p = n0 + (lane & 31); const int src = projmap ? proj_src(p) : p;
    float wv[32];
#pragma unroll
    for (int i = 0; i < 32; ++i) { const int kk = 2 * i + (lane >> 5); wv[i] = src >= 0 ? W[(size_t)(k0 + kk) * Nsrc + src] : 0.f; }
    if (scale) {
#pragma unroll
        for (int i = 0; i < 32; ++i) wv[i] *= scale[k0 + 2 * i + (lane >> 5)];
    }
#pragma unroll
    for (int i = 0; i < 32; ++i) scr[(2 * i + (lane >> 5)) * 33 + (lane & 31)] = wv[i];
    asm volatile("s_waitcnt lgkmcnt(0)" ::: "memory");
    const int c = lane & 7;
#pragma unroll
    for (int j = 0; j < 4; ++j) { const int n = (lane >> 3) + 8 * j; const LAS float* s = scr + (8 * c) * 33 + n;
        u32x4 o; o.x = cvtpk(s[0 * 33], s[1 * 33]); o.y = cvtpk(s[2 * 33], s[3 * 33]); o.z = cvtpk(s[4 * 33], s[5 * 33]); o.w = cvtpk(s[6 * 33], s[7 * 33]);
        *(u32x4*)(out + (size_t)(row_off + n0 + n) * K + k0 + 8 * c) = o; }
    asm volatile("s_waitcnt lgkmcnt(0)" ::: "memory");
}
constexpr int PREP_EARLY = 480, PREP_LATE = 448, PREP_SMALL = 64, PREP_UNITS = PREP_EARLY + PREP_LATE + PREP_SMALL;
__device__ __forceinline__ void prep_unit(const Ptrs& P, LAS unsigned char* lds, int layer, int u, int tid, int lane, int wid) {
    unsigned char* W = wbase(P.ws, P.out, layer);
    if (u < PREP_EARLY + PREP_LATE) {
        LAS float* scr = (LAS float*)(lds + wid * 8704);
        const float* w_in = P.in[2] + (size_t)layer * DM * D_IN; const float* g_pre = P.in[3] + layer * DM; const float* g_mem = P.in[5] + layer * DM;
        const float* w_mem = P.in[6] + (size_t)layer * DM * 1024; const float* w_br = P.in[18] + (size_t)layer * 4 * 512 * 1024; const float* w_gate = P.in[19] + (size_t)layer * DM * 4096; const float* w_o = P.in[20] + (size_t)layer * DM * DM;
        constexpr int I1 = 16 * (NP1 / 32), I2 = 16 * (NGATE / 32), I3 = 8 * 32, I4 = 16 * 32, I5 = 16 * 32;
        static_assert(I1 + I5 == 8 * PREP_EARLY && I2 + 4 * I3 + I4 == 8 * PREP_LATE, "prep unit counts");
        if (u < PREP_EARLY) { int r = 8 * u + wid;
            if (r < I1) prep_item(w_in, DM, D_IN, g_pre, (bf16*)(W + W_IN), 0, NP1, true, scr, r, lane);
            else prep_item(w_mem, DM, 1024, g_mem, (bf16*)(W + W_M), 0, 1024, false, scr, r - I1, lane);
        } else { int r = 8 * (u - PREP_EARLY) + wid;
            if (r < I2) prep_item(w_gate, DM, NGATE, g_pre, (bf16*)(W + W_IN), NP1, NGATE, false, scr, r, lane);
            else if (r < I2 + 4 * I3) { r -= I2; const int n = r / I3; prep_item(w_br + (size_t)n * 512 * 1024, 512, 1024, nullptr, (bf16*)(W + W_BR) + (size_t)n * 1024 * 512, 0, 1024, false, scr, r % I3, lane); }
            else prep_item(w_o, DM, DM, nullptr, (bf16*)(W + W_O), 0, 1024, false, scr, r - I2 - 4 * I3, lane);
        }
    } else {
        const int c = u - PREP_EARLY - PREP_LATE;
        const float* w1k = P.in[12] + (size_t)layer * 2048 * 64; const float* w2k = P.in[13] + layer * 4096; const float* w1v = P.in[15] + (size_t)layer * 2048 * 64; const float* w2v = P.in[16] + layer * 4096;
        const float* a_ws = P.in[9] + (size_t)layer * 4 * 128 * 128;
        bf16* W1K = (bf16*)(W + W_1K); bf16* W1V = (bf16*)(W + W_1V); bf16* W2K = (bf16*)(W + W_2K); bf16* W2V = (bf16*)(W + W_2V); bf16* WSP = (bf16*)(W + W_WS);
#pragma unroll
        for (int q = 0; q < 4; ++q) { const int i = c * 2048 + q * 512 + tid; const int e = i >> 11, kk = i & 2047, l = kk >> 6, pp = kk & 63;
            W1K[i] = (bf16)(cvtpk(w1k[(size_t)(l * 64 + dperm(pp)) * 64 + e], 0.f) & 0xffffu); W1V[i] = (bf16)(cvtpk(w1v[(size_t)kk * 64 + e], 0.f) & 0xffffu); }
        if (tid < 64) { const int i = c * 64 + tid; const int e2 = i >> 6, h = i & 63; W2K[i] = (bf16)(cvtpk(w2k[h * 64 + dperm(e2)], 0.f) & 0xffffu); W2V[i] = (bf16)(cvtpk(w2v[h * 64 + e2], 0.f) & 0xffffu); }
#pragma unroll
        for (int q = 0; q < 2; ++q) { const int i = c * 1024 + q * 512 + tid; const int t = (i >> 7) & 127, s = i & 127; WSP[i] = (bf16)(cvtpk(s <= t ? a_ws[i] : 0.f, 0.f) & 0xffffu); }
        if (wid < 2) { const int o = 2 * c + wid; const int which = o >> 6, e = o & 63; const float* pos = (which ? P.in[14] : P.in[11]) + layer * 2048; const float* w1 = which ? w1v : w1k; float s = 0.f;
#pragma unroll
            for (int ii = 0; ii < 32; ++ii) { const int i = lane + 64 * ii; s += pos[i] * w1[(size_t)i * 64 + e]; }
            s = wave_sum(s); if (lane == 0) ((float*)(P.ws + WS_BIAS1))[o] = s; }
    }
}
__device__ __forceinline__ void prologue(const Ptrs& P, LAS unsigned char* lds, int gw, int ngw, int gtid, int ngt, int lane, int wid) {
    for (int u = blockIdx.x; u < PREP_EARLY + PREP_SMALL; u += gridDim.x) prep_unit(P, lds, 0, u < PREP_EARLY ? u : u + PREP_LATE, wid * 64 + lane, lane, wid);
    float* rc = (float*)(P.ws + WS_ROPEC); float* rs = (float*)(P.ws + WS_ROPES);
    for (int idx = gtid; idx < SEQ * 32; idx += ngt) { const int pos = idx >> 5, i = idx & 31;
        double f = 1.0; for (int k = 0; k < i; ++k) f *= 0.7498942093324559;
        const double x2 = f * f; double cs = 1.0, sn = f, tc = 1.0, ts = f;
        for (int k = 1; k <= 12; ++k) { tc *= -x2 / (double)((2 * k - 1) * (2 * k)); ts *= -x2 / (double)((2 * k) * (2 * k + 1)); cs += tc; sn += ts; }
        double rcv = 1.0, rsv = 0.0, bc = cs, bs = sn;
        for (int bit = 0; bit < 11; ++bit) { if ((pos >> bit) & 1) { const double a = rcv * bc - rsv * bs, b2 = rcv * bs + rsv * bc; rcv = a; rsv = b2; } const double nc = bc * bc - bs * bs, ns = 2.0 * bc * bs; bc = nc; bs = ns; }
        rc[idx] = (float)rcv; rs[idx] = (float)rsv; }
    const float* x = P.in[0]; const float* mem = P.in[1]; bf16* XB = (bf16*)(P.ws + WS_XB); bf16* MEMB = (bf16*)(P.ws + WS_MEMB); float* rinv = (float*)(P.ws + WS_RINV); float* rinvm = (float*)(P.ws + WS_RINVM);
    constexpr int NR = 4;
    for (int r0 = gw; r0 < NT + NMEM; r0 += NR * ngw) {
        f32x4 v[NR][4];
#pragma unroll
        for (int q = 0; q < NR; ++q) { const int r = r0 + q * ngw; if (r < NT + NMEM) { const bool ism = r >= NT; const int row = ism ? r - NT : r; const float* src = (ism ? mem : x) + (size_t)row * DM;
#pragma unroll
            for (int j = 0; j < 4; ++j) v[q][j] = *(const f32x4*)(src + 4 * lane + 256 * j); } }
#pragma unroll
        for (int q = 0; q < NR; ++q) { const int r = r0 + q * ngw; if (r < NT + NMEM) { const bool ism = r >= NT; const int row = ism ? r - NT : r; bf16* dst = (ism ? MEMB : XB) + (size_t)row * DM; float ss = 0.f;
#pragma unroll
            for (int j = 0; j < 4; ++j) { const f32x4 w4 = v[q][j]; ss += (w4[0] * w4[0] + w4[1] * w4[1]) + (w4[2] * w4[2] + w4[3] * w4[3]); u32x2 w; w.x = cvtpk(w4[0], w4[1]); w.y = cvtpk(w4[2], w4[3]); *(u32x2*)(dst + 4 * lane + 256 * j) = w; }
            ss = wave_sum(ss); if (lane == 0) (ism ? rinvm : rinv)[row] = 1.f / sqrtf(ss * (1.f / DM) + EPS); } }
    }
}
__device__ __forceinline__ void finish_layer(const Ptrs& P, int layer, int gw, int ngw, int lane) {
    float* OUT = (float*)P.out; const bf16* OUTB = (const bf16*)gate_ptr(P.ws, P.out, 0); const float* part = (const float*)(P.ws + WS_PART); const float* gp = P.in[4] + layer * DM; const float* x = P.in[0];
    bf16* XB = (bf16*)(P.ws + WS_XB); float* rinv = (float*)(P.ws + WS_RINV);
    f32x4 g4[4];
#pragma unroll
    for (int j = 0; j < 4; ++j) g4[j] = *(const f32x4*)(gp + 4 * lane + 256 * j);
    constexpr int NR = 4;
    for (int row0 = gw; row0 < NT; row0 += NR * ngw) {
        f32x4 o4[NR][4], xv[NR][4]; float sp[NR];
#pragma unroll
        for (int q = 0; q < NR; ++q) { const int row = row0 + q * ngw; if (row < NT) { sp[q] = part[(size_t)row * 16 + (lane & 15)];
#pragma unroll
            for (int j = 0; j < 4; ++j) { const size_t off = (size_t)row * DM + 4 * lane + 256 * j; { const u32x2 w = *(const u32x2*)(OUTB + off); o4[q][j] = (f32x4){bflo(w.x), bfhi(w.x), bflo(w.y), bfhi(w.y)}; }
                { const u32x2 w = *(const u32x2*)(XB + off); xv[q][j] = (f32x4){bflo(w.x), bfhi(w.x), bflo(w.y), bfhi(w.y)}; } } } }
#pragma unroll
        for (int q = 0; q < NR; ++q) { const int row = row0 + q * ngw; if (row < NT) {
            float s = sp[q]; s += __shfl_xor(s, 1); s += __shfl_xor(s, 2); s += __shfl_xor(s, 4); s += __shfl_xor(s, 8);
            const float rs = 1.f / sqrtf(s * (1.f / DM) + EPS); float ss = 0.f;
#pragma unroll
            for (int j = 0; j < 4; ++j) { const size_t off = (size_t)row * DM + 4 * lane + 256 * j; const f32x4 xn = xv[q][j] + o4[q][j] * rs * g4[j];
                if (layer == 0) { ss += (xn[0] * xn[0] + xn[1] * xn[1]) + (xn[2] * xn[2] + xn[3] * xn[3]); u32x2 w; w.x = cvtpk(xn[0], xn[1]); w.y = cvtpk(xn[2], xn[3]); *(u32x2*)(XB + off) = w; }
                else *(f32x4*)(OUT + off) = xn; }
            if (layer == 0) { ss = wave_sum(ss); if (lane == 0) rinv[row] = 1.f / sqrtf(ss * (1.f / DM) + EPS); } } }
    }
}

struct Args { Ptrs p; int nph; unsigned char prog[28]; };
constexpr int NPHASE = 13;
struct GateOrder {
    pg8::StaticOrder base;
    __device__ void init(int G, int c) { base.init(NT, DM, G, c); }
    __device__ bool next(int i, pg8::Unit& u) const { if (!base.next(i >> 2, u)) return false; u.pn += 4 * (i & 3); return true; }
    __device__ __forceinline__ void a_ready(const pg8::Unit&) const {}
    __device__ __forceinline__ void done(const pg8::Unit&) const {}
};
__device__ __forceinline__ int dequeue(unsigned* ctr, LAS int* slot, int tid) {
    __syncthreads();
    if (tid == 0) *slot = (int)atomicAdd(ctr, 1u);
    __syncthreads();
    return *slot;
}
#define QUEUE_LOOP(ctr, qslot, tid0, LIMIT, ...) do { \
        for (;;) { const int idx = dequeue(ctr, qslot, tid0); if (idx >= (LIMIT)) break; \
            { __VA_ARGS__ } } } while (0)

template <int KIND> __device__ __forceinline__ void run_phase(const Ptrs& P, LAS unsigned char* lds, int ph, int qi, int tid, int lane_in, int wid) {
    const int lane = lane_in;
    int G = gridDim.x, bid = blockIdx.x; asm volatile("" : "+s"(G), "+s"(bid));
    const int gw = bid * 8 + wid, ngw = G * 8, gtid = bid * 512 + tid, ngt = G * 512;
    unsigned* ctl = (unsigned*)(P.ws + WS_CTL); LAS int* qslot = (LAS int*)(lds + LDS_MISC);
    if (ph == 0) { if (KIND < 0 || KIND == 0) prologue(P, lds, gw, ngw, gtid, ngt, lane, wid); }
        else if (ph < NPHASE) {
            const int layer = (ph - 1) / 6, sub = (ph - 1) % 6; unsigned char* W = wbase(P.ws, P.out, layer);
            if (sub == 0 && (KIND < 0 || KIND == 1)) {
                { pg8::Gemm g{(const bf16*)(P.ws + WS_XB), (const bf16*)(W + W_IN), NT, NP1, DM}; pg8::StaticOrder S; S.init(NT, NP1, G, bid);
                  pg8::EpiG1 E{P.ws, P.out, (const float*)(P.ws + WS_RINV), P.in[17] + layer * 8, (const float*)(P.ws + WS_ROPEC), (const float*)(P.ws + WS_ROPES), (float*)(P.ws + WS_SM)};
                  pg8::gemm_phase<pg8::EpiG1, pg8::StaticOrder, true, true>(lds, g, S, E, tid); }
                { int tid2 = tid; asm volatile("" : "+v"(tid2)); const int tid = tid2;
                  pg8::Gemm g{(const bf16*)(P.ws + WS_MEMB), (const bf16*)(W + W_M), NMEM, 1024, DM}; pg8::StaticOrder S; S.init(NMEM, 1024, G, (bid + G / 2) % G);
                  pg8::EpiRowScale E{(bf16*)(P.ws + WS_MKV), 1024, (const float*)(P.ws + WS_RINVM)};
                  pg8::gemm_phase<pg8::EpiRowScale, pg8::StaticOrder, true, true>(lds, g, S, E, tid); }
            } else if (sub == 1 && (KIND < 0 || KIND == 2)) {
                unsigned* ctr = ctl + CW_Q + 16 * qi;
                QUEUE_LOOP(ctr, qslot, tid, 576, {
                    int lane = lane_in; asm volatile("" : "+v"(lane)); const int tid = wid * 64 + lane;
                    if (idx < 128) cmp_item(P, lds, layer, (idx >> 2) & 7, (idx >> 1) & 1, idx & 1, idx >> 5, lane, wid);
                    else if (idx < 192) { const int i = idx - 128; cumsum_item(P, lds, i >> 3, i & 7, tid, lane, wid); }
                    else if (idx < 320) { const int i = idx - 192; gmlp_item(P, lds, layer, i >> 4, i & 15, tid, lane, wid); }
                    else { const int i = idx - 320; mem_item(P, lds, i >> 5, (i >> 3) & 3, i & 7, tid, lane, wid); } });
            } else if (sub == 2 && (KIND < 0 || KIND == 3)) {
                unsigned* ctr = ctl + CW_Q + 16 * qi;
                QUEUE_LOOP(ctr, qslot, tid, (layer == 0 ? 1024 + PREP_LATE + PREP_UNITS : 1024), {
                    int lane = lane_in; asm volatile("" : "+v"(lane)); const int tid = wid * 64 + lane;
                    if (idx >= 1024) { const int f = idx - 1024; if (f < PREP_LATE) prep_unit(P, lds, 0, PREP_EARLY + f, tid, lane, wid); else prep_unit(P, lds, 1, f - PREP_LATE, tid, lane, wid); continue; }
                    int isn, i, q;
                    if (idx < 256) { isn = 1; i = idx; q = 31 - (i >> 4); }
                    else if (idx < 512) { isn = 0; i = idx - 256; q = 7 - (i >> 6); }
                    else if (idx < 640) { isn = 1; i = idx - 512; q = 15 - (i >> 4); }
                    else if (idx < 768) { isn = 0; i = idx - 640; q = 3 - (i >> 6); }
                    else if (idx < 896) { isn = 1; i = idx - 768; q = 7 - (i >> 4); }
                    else { isn = 0; i = idx - 896; q = 1 - (i >> 6); }
                    if (isn) nsa_item(P, lds, (i & 15) >> 1, i & 1, q, tid, lane, wid);
                    else fa_item(P, lds, (i & 63) >> 3, i & 7, q, tid, lane, wid); });
            } else if (sub == 3 && (KIND < 0 || KIND == 4)) {
                unsigned char* g0 = gate_ptr(P.ws, P.out, 0); unsigned char* g1 = gate_ptr(P.ws, P.out, 1); unsigned char* g2 = gate_ptr(P.ws, P.out, 2); unsigned char* g3 = gate_ptr(P.ws, P.out, 3);
                { pg8::Gemm g{(const bf16*)(P.ws + WS_XB), (const bf16*)(W + W_IN) + (size_t)NP1 * DM, NT, NGATE, DM}; GateOrder S; S.init(G, bid);
                  pg8::EpiGate E{g0, g1, g2, g3, (const float*)(P.ws + WS_RINV)};
                  pg8::gemm_phase<pg8::EpiGate, GateOrder, true, true>(lds, g, S, E, tid); }
                { int tid2 = tid; asm volatile("" : "+v"(tid2)); const int tid = tid2;
                  pg8::Gemm g{(const bf16*)slot_ptr(P.ws, P.out, 0), (const bf16*)(W + W_BR), 4 * NT, 4096, 512}; pg8::MergeOrder S; S.init(G, bid);
                  pg8::EpiMerge E{g0, g1, g2, g3, (bf16*)(P.ws + WS_MERGED)};
                  pg8::gemm_phase<pg8::EpiMerge, pg8::MergeOrder, true, true>(lds, g, S, E, tid); }
            } else if (sub == 4 && (KIND < 0 || KIND == 5)) {
                pg8::Gemm g{(const bf16*)(P.ws + WS_MERGED), (const bf16*)(W + W_O), NT, DM, DM}; pg8::StaticOrder S; S.init(NT, DM, G, bid);
                pg8::EpiOut E{(bf16*)gate_ptr(P.ws, P.out, 0), (float*)(P.ws + WS_PART)};
                pg8::gemm_phase<pg8::EpiOut, pg8::StaticOrder, true, true>(lds, g, S, E, tid);
            } else if (sub == 5 && (KIND < 0 || KIND == 6)) {
                finish_layer(P, layer, gw, ngw, lane);
            }
        }
}
#define XB_TMO      128
#define XB_XCNT(j)  (256  + 64 * (j))
#define XB_XSUB(j)  (1280 + 64 * (j))
#define XB_XGEN(j)  (2304 + 64 * (j))
#define XB_TOP      3328
#define XB_TOPGEN   3392
#define XCD_BAR_WORDS 3456
#define XB_SPIN_CAP (1u << 18)

__device__ __forceinline__ unsigned xb_ld(unsigned* p)              { return __hip_atomic_load(p, __ATOMIC_RELAXED, __HIP_MEMORY_SCOPE_AGENT); }
__device__ __forceinline__ unsigned xb_add(unsigned* p, unsigned v) { return __hip_atomic_fetch_add(p, v, __ATOMIC_RELAXED, __HIP_MEMORY_SCOPE_AGENT); }
__device__ __forceinline__ unsigned xb_xcc_id() { return (unsigned)__builtin_amdgcn_s_getreg((3 << 11) | 20) & 0xFu; }
#define XB_SPIN(cond, bar) do { unsigned _sp = 0; while (cond) { __builtin_amdgcn_s_sleep(1); \
    if ((++_sp & 255u) == 0u) { if (xb_ld(&(bar)[XB_TMO])) break; if (_sp > XB_SPIN_CAP) { atomicAdd(&(bar)[XB_TMO], 1u); break; } } } } while (0)

struct XcdBarrier {
    unsigned* bar; unsigned x;
    volatile LAS unsigned* st;
};

__device__ __forceinline__ XcdBarrier xcd_barrier_post(unsigned* bar, volatile LAS unsigned* st) {
    XcdBarrier b; b.bar = bar; b.x = xb_xcc_id(); b.st = st;
    if (threadIdx.x == 0) (void)xb_add(&bar[XB_XCNT(b.x)], 1u);
    return b;
}
__device__ __forceinline__ void xcd_barrier_complete(unsigned* bar, unsigned x, unsigned& nloc, unsigned& nx) {
    const unsigned G = gridDim.x * gridDim.y * gridDim.z;
    unsigned sum, cnt, mine, sp = 0u;
    for (;;) {
        sum = 0u; cnt = 0u; mine = 0u;
#pragma unroll
        for (unsigned j = 0; j < 16; ++j) { const unsigned c = xb_ld(&bar[XB_XCNT(j)]); sum += c; cnt += (c > 0u) ? 1u : 0u; mine = (j == x) ? c : mine; }
        if (sum == G) break;
        __builtin_amdgcn_s_sleep(1);
        if ((++sp & 255u) == 0u) { if (xb_ld(&bar[XB_TMO])) break; if (sp > XB_SPIN_CAP) { atomicAdd(&bar[XB_TMO], 1u); break; } }
    }
    nloc = mine > 0u ? mine : 1u; nx = cnt > 0u ? cnt : 1u;
}

__device__ __forceinline__ void xcd_barrier(const XcdBarrier& b) {
    asm volatile("s_waitcnt vmcnt(0)" ::: "memory");
    __syncthreads();
    if (threadIdx.x == 0) {
        unsigned* bar = b.bar;
        __builtin_amdgcn_s_waitcnt(0);
        unsigned nloc = b.st[0], nx = b.st[1];
        if (nloc == 0u) { xcd_barrier_complete(bar, b.x, nloc, nx); b.st[0] = nloc; b.st[1] = nx; }
        const unsigned old = xb_add(&bar[XB_XSUB(b.x)], 1u);
        const unsigned gen = old / nloc;
        if (old + 1u == (gen + 1u) * nloc) {
            __builtin_amdgcn_fence(__ATOMIC_RELEASE, "agent");
            asm volatile("s_waitcnt vmcnt(0)" ::: "memory");
            const unsigned og = xb_add(&bar[XB_TOP], 1u);
            const unsigned tg = og / nx;
            if (og + 1u == (tg + 1u) * nx) xb_add(&bar[XB_TOPGEN], 1u);
            else XB_SPIN(xb_ld(&bar[XB_TOPGEN]) == tg, bar);
            __builtin_amdgcn_fence(__ATOMIC_ACQUIRE, "agent");
            xb_add(&bar[XB_XGEN(b.x)], 1u);
            asm volatile("s_waitcnt vmcnt(0)" ::: "memory");
        } else {
            XB_SPIN(xb_ld(&bar[XB_XGEN(b.x)]) == gen, bar);
            __builtin_amdgcn_fence(__ATOMIC_ACQUIRE, "agent");
            asm volatile("s_waitcnt vmcnt(0)" ::: "memory");
        }
    }
    __syncthreads();
}

constexpr int CW_BAR = 4096;
typedef const __attribute__((address_space(4))) Args* KArgP;
__global__ void __launch_bounds__(512, 2) hybrid_fwd(Args a_unused) {
    extern __shared__ __attribute__((aligned(16))) unsigned char lds_raw[];
    KArgP kp = (KArgP)__builtin_amdgcn_kernarg_segment_ptr();
    const int nph = kp->nph;
    const int wid0 = __builtin_amdgcn_readfirstlane((int)threadIdx.x >> 6);
    {
        volatile LAS unsigned* st = (volatile LAS unsigned*)((LAS unsigned char*)lds_raw + LDS_MISC + 16);
        if (threadIdx.x < 2) st[threadIdx.x] = 0u;
        __syncthreads();
        (void)xcd_barrier_post((unsigned*)(kp->p.ws + WS_CTL) + CW_BAR, st);
    }
    for (int pi = 0; pi < nph; ++pi) {
        int wid = wid0; asm volatile("" : "+s"(wid));
        int lane; asm volatile("v_mbcnt_lo_u32_b32 %0, -1, 0\n\tv_mbcnt_hi_u32_b32 %0, -1, %0" : "=v"(lane));
        const int tid = wid * 64 + lane;
        KArgP kq = kp; asm volatile("" : "+s"(kq));
        LAS unsigned char* lds = (LAS unsigned char*)lds_raw;
        Ptrs P;
#pragma unroll
        for (int i = 0; i < 21; ++i) P.in[i] = kq->p.in[i];
        P.out = kq->p.out; P.ws = kq->p.ws;
        const int ph = kq->prog[pi];
        run_phase<-1>(P, lds, ph, pi, tid, lane, wid);
        if (pi + 1 < nph) {
            if (nph > 64) cg::this_grid().sync();
            else { XcdBarrier b; b.bar = (unsigned*)(P.ws + WS_CTL) + CW_BAR; b.x = xb_xcc_id(); b.st = (volatile LAS unsigned*)(lds + LDS_MISC + 16); xcd_barrier(b); }
        }
    }
}
#ifdef DIAG_KERNELS
template <int KIND> __global__ void __launch_bounds__(512, 2) phase_k(Args a) {
    extern __shared__ __attribute__((aligned(16))) unsigned char lds_raw[];
    LAS unsigned char* lds = (LAS unsigned char*)lds_raw;
    const int tid = threadIdx.x, lane = tid & 63, wid = __builtin_amdgcn_readfirstlane(tid >> 6);
    run_phase<KIND>(a.p, lds, a.prog[0], 0, tid, lane, wid);
}
template __global__ void phase_k<0>(Args);
template __global__ void phase_k<1>(Args);
template __global__ void phase_k<2>(Args);
template __global__ void phase_k<3>(Args);
template __global__ void phase_k<4>(Args);
template __global__ void phase_k<5>(Args);
template __global__ void phase_k<6>(Args);

#endif
extern "C" void kernel_launch(void* const* d_in, const int* in_sizes, int n_in, void* d_out, int out_size, void* d_ws, size_t ws_size, hipStream_t stream) {
    static int grid = 0;
    if (grid == 0) {
        if (n_in != 21 || out_size != NT * DM || ws_size < WS_NEED) { fprintf(stderr, "kernel_launch: unexpected shapes (n_in %d out %d ws %zu)\n", n_in, out_size, ws_size); grid = -1; return; }
        int dev = 0, cus = 0, per_cu = 0;
        hipGetDevice(&dev); hipDeviceGetAttribute(&cus, hipDeviceAttributeMultiprocessorCount, dev);
        if (hipFuncSetAttribute((const void*)hybrid_fwd, hipFuncAttributeMaxDynamicSharedMemorySize, LDS_BYTES) != hipSuccess) { fprintf(stderr, "kernel_launch: hipFuncSetAttribute failed\n"); grid = -1; return; }
        hipOccupancyMaxActiveBlocksPerMultiprocessor(&per_cu, (const void*)hybrid_fwd, 512, LDS_BYTES);
        (void)hipGetLastError();
        if (per_cu < 1) { fprintf(stderr, "kernel_launch: occupancy query reports %d blocks per CU\n", per_cu); per_cu = 1; }
        grid = cus;
        if (grid % 8 != 0) grid -= grid % 8;
    }
    if (grid < 0) return;
    (void)hipMemsetAsync((char*)d_ws + WS_CTL, 0, 32768, stream);
    Args a{};
    for (int i = 0; i < 21; ++i) a.p.in[i] = (const float*)d_in[i];
    a.p.out = (unsigned char*)d_out; a.p.ws = (unsigned char*)d_ws;
    int n = 0;
#ifdef PROG_CUSTOM
    { const unsigned char pc[] = PROG_CUSTOM; for (unsigned i = 0; i < sizeof(pc); ++i) a.prog[n++] = pc[i]; }
#else
    for (int ph = 0; ph < NPHASE; ++ph) a.prog[n++] = (unsigned char)ph;
#endif
#if ONE_LAUNCH
    a.nph = n;
    void* args[] = {&a};
    hipError_t e = hipLaunchCooperativeKernel((const void*)hybrid_fwd, dim3(grid), dim3(512), args, LDS_BYTES, stream);
    if (e != hipSuccess) fprintf(stderr, "kernel_launch: cooperative launch failed: %s (grid %d)\n", hipGetErrorString(e), grid);
#else
    { Args b = a; b.nph = 1; for (int i = 0; i < n; ++i) { b.prog[0] = a.prog[i]; hipLaunchKernelGGL(hybrid_fwd, dim3(grid), dim3(512), LDS_BYTES, stream, b); } }
#endif
}
```
